# Optimizing an MI355X kernel written in HIP

```python
import math
import jax
import jax.numpy as jnp
from jax import lax
import numpy as np

D_MODEL = 1024
BATCH = 16
SEQ = 4096
DEPTH = 1
DEC_BATCH = 4
DEC_SEQ = 4096
PAST_LEN = 128

HEAD_DIM = 64
A_Q_HEADS = 8
A_KV_HEADS = 2
A_GROUP = A_Q_HEADS // A_KV_HEADS
WINDOW = 128
BLOCK = 128
B_HEADS = 4
B_DIM = 64
A_Q = A_Q_HEADS * HEAD_DIM
A_KV = A_KV_HEADS * HEAD_DIM
B_QK = B_HEADS * 2 * B_DIM
B_V = B_HEADS * 2 * B_DIM
A_OUT = A_Q
B_OUT = B_V
IN_SPLITS = (A_Q, A_Q + A_KV, A_Q + 2 * A_KV, A_Q + 2 * A_KV + B_QK, A_Q + 2 * A_KV + 2 * B_QK, A_Q + 2 * A_KV + 2 * B_QK + B_V, A_Q + 2 * A_KV + 2 * B_QK + B_V + D_MODEL)
IN_TOTAL = A_Q + 2 * A_KV + 2 * B_QK + B_V + 2 * D_MODEL
D_FF = ((8 * D_MODEL + 3 * 256 - 1) // (3 * 256)) * 256
ROPE_THETA = 10000.0
ALPHA = (2.0 * DEPTH) ** 0.25
BETA = (8.0 * DEPTH) ** -0.25
LN_EPS = 1e-5
RMS_EPS = 1e-5
NEG = -1e30

kernel_name = 'hybrid_gated_window_diff_encoder'


def lambda_init(layer):
    return 0.8 - 0.6 * math.exp(-0.3 * layer)


def layer_norm(x, g, b):
    xf = x.astype(jnp.float32)
    xc = xf - xf.mean(-1, keepdims=True)
    var = (xc * xc).mean(-1, keepdims=True)
    return (xc * lax.rsqrt(var + LN_EPS) * g.astype(jnp.float32) + b.astype(jnp.float32)).astype(x.dtype)


def head_rmsnorm(x, w):
    xf = x.astype(jnp.float32)
    y = xf * lax.rsqrt((xf * xf).mean(-1, keepdims=True) + RMS_EPS) * w.astype(jnp.float32)
    return y.astype(x.dtype)


def rope_tables(seq_len, dim):
    inv = 1.0 / (ROPE_THETA ** (jnp.arange(0, dim, 2, dtype=jnp.float32) / dim))
    ang = jnp.arange(seq_len, dtype=jnp.float32)[:, None] * inv[None, :]
    return jnp.cos(ang), jnp.sin(ang)


def apply_rope(x, cos, sin):
    shp = (cos.shape[0],) + (1,) * (x.ndim - 3) + (cos.shape[1],)
    c = cos.reshape(shp).astype(x.dtype)
    s = sin.reshape(shp).astype(x.dtype)
    x1, x2 = jnp.split(x, 2, axis=-1)
    return jnp.concatenate([x1 * c - x2 * s, x2 * c + x1 * s], axis=-1)


def window_gqa(q, k, v, sink):
    bsz, seq = q.shape[0], q.shape[1]
    nb = seq // BLOCK
    qb = q.reshape(bsz, nb, BLOCK, A_KV_HEADS, A_GROUP, HEAD_DIM)
    pad = ((0, 0), (1, 1), (0, 0), (0, 0), (0, 0))
    kp = jnp.pad(k.reshape(bsz, nb, BLOCK, A_KV_HEADS, HEAD_DIM), pad)
    vp = jnp.pad(v.reshape(bsz, nb, BLOCK, A_KV_HEADS, HEAD_DIM), pad)
    kb = jnp.concatenate([kp[:, :-2], kp[:, 1:-1], kp[:, 2:]], axis=2)
    vb = jnp.concatenate([vp[:, :-2], vp[:, 1:-1], vp[:, 2:]], axis=2)
    s = jnp.einsum('bnqhgd,bnkhd->bnhgqk', qb, kb).astype(jnp.float32) * (HEAD_DIM ** -0.5)
    blk = jnp.arange(nb)
    qpos = blk[:, None] * BLOCK + jnp.arange(BLOCK)[None, :]
    kpos = (blk[:, None] - 1) * BLOCK + jnp.arange(3 * BLOCK)[None, :]
    kp3 = kpos[:, None, :]
    valid = (jnp.abs(qpos[:, :, None] - kp3) <= WINDOW) & (kp3 >= 0) & (kp3 < seq)
    s = jnp.where(valid[None, :, None, None], s, NEG)
    sk = sink.astype(jnp.float32).reshape(1, 1, A_KV_HEADS, A_GROUP, 1, 1)
    m = jnp.maximum(s.max(-1, keepdims=True), sk)
    e = jnp.exp(s - m)
    p = e / (e.sum(-1, keepdims=True) + jnp.exp(sk - m))
    o = jnp.einsum('bnhgqk,bnkhd->bnqhgd', p.astype(v.dtype), vb)
    return o.reshape(bsz, seq, A_Q)


def diff_attention(q, k, v, lam):
    bsz, seq = q.shape[0], q.shape[1]
    nb = seq // BLOCK
    qb = q.reshape(bsz, nb, BLOCK, B_HEADS, 2, B_DIM).transpose(1, 0, 2, 3, 4, 5)
    scale = B_DIM ** -0.5

    def one_block(qblk):
        s = jnp.einsum('bqhcd,bkhcd->bhcqk', qblk, k).astype(jnp.float32) * scale
        p = jax.nn.softmax(s, axis=-1)
        a = p[:, :, 0] - lam * p[:, :, 1]
        return jnp.einsum('bhqk,bkhe->bqhe', a.astype(v.dtype), v)

    o = lax.map(one_block, qb)
    return o.transpose(1, 0, 2, 3, 4).reshape(bsz, seq, B_HEADS, 2 * B_DIM)


def encoder_layer(x, c, cos, sin, layer, w_ada, b_ada, w_in, sink_logit, lam_q1, lam_k1, lam_q2, lam_k2, subln_w, w_a, w_b, w_o, ln1_g, ln1_b, w_gu, w_down, ln2_g, ln2_b):
    bsz, seq, _ = x.shape
    mod = (jax.nn.silu(c) @ w_ada + b_ada).reshape(bsz, 6, 1, D_MODEL)
    shift_m, scale_m, gate_m = mod[:, 0], mod[:, 1], mod[:, 2]
    shift_f, scale_f, gate_f = mod[:, 3], mod[:, 4], mod[:, 5]

    h = x * (1.0 + scale_m) + shift_m
    qa, ka, va, qd, kd, vd, ga, gb = jnp.split(h @ w_in, IN_SPLITS, axis=-1)
    qa = apply_rope(qa.reshape(bsz, seq, A_Q_HEADS, HEAD_DIM), cos, sin)
    ka = apply_rope(ka.reshape(bsz, seq, A_KV_HEADS, HEAD_DIM), cos, sin)
    va = va.reshape(bsz, seq, A_KV_HEADS, HEAD_DIM)
    a_out = window_gqa(qa, ka, va, sink_logit) @ w_a

    lam_i = lambda_init(layer)
    lam = (jnp.exp(jnp.sum(lam_q1.astype(jnp.float32) * lam_k1.astype(jnp.float32)))
           - jnp.exp(jnp.sum(lam_q2.astype(jnp.float32) * lam_k2.astype(jnp.float32))) + lam_i)
    qd = apply_rope(qd.reshape(bsz, seq, B_HEADS, 2, B_DIM), cos, sin)
    kd = apply_rope(kd.reshape(bsz, seq, B_HEADS, 2, B_DIM), cos, sin)
    vd = vd.reshape(bsz, seq, B_HEADS, 2 * B_DIM)
    od = head_rmsnorm(diff_attention(qd, kd, vd, lam), subln_w) * (1.0 - lam_i)
    b_out = od.reshape(bsz, seq, B_OUT) @ w_b

    merged = jax.nn.sigmoid(ga) * a_out + jax.nn.sigmoid(gb) * b_out
    x = layer_norm(ALPHA * x + gate_m * (merged @ w_o), ln1_g, ln1_b)

    h = x * (1.0 + scale_f) + shift_f
    g, u = jnp.split(h @ w_gu, 2, axis=-1)
    f = (jax.nn.silu(g) * u) @ w_down
    return layer_norm(ALPHA * x + gate_f * f, ln2_g, ln2_b)


def run_trunk(x, c, w_ada, b_ada, w_in, sink_logit, lam_q1, lam_k1, lam_q2, lam_k2, subln_w, w_a, w_b, w_o, ln1_g, ln1_b, w_gu, w_down, ln2_g, ln2_b):
    cos, sin = rope_tables(x.shape[1], HEAD_DIM)
    for l in range(DEPTH):
        x = encoder_layer(x, c, cos, sin, l, w_ada[l], b_ada[l], w_in[l], sink_logit[l], lam_q1[l], lam_k1[l], lam_q2[l], lam_k2[l], subln_w[l], w_a[l], w_b[l], w_o[l], ln1_g[l], ln1_b[l], w_gu[l], w_down[l], ln2_g[l], ln2_b[l])
    return x


def setup_inputs(seed: int = 0) -> dict:
    key = jax.random.key(seed)
    ks = jax.random.split(key, 22)

    def nrm(k, shape, s):
        return jax.random.normal(k, shape, jnp.float32) * s

    return {
        'x_prompt': nrm(ks[0], (BATCH, SEQ, D_MODEL), 1.0),
        'x_sample': nrm(ks[1], (DEC_BATCH, DEC_SEQ, D_MODEL), 1.0),
        'c_prompt': nrm(ks[2], (BATCH, D_MODEL), 1.0),
        'c_sample': nrm(ks[3], (DEC_BATCH, D_MODEL), 1.0),
        'w_ada': nrm(ks[4], (DEPTH, D_MODEL, 6 * D_MODEL), 0.5 * D_MODEL ** -0.5),
        'b_ada': nrm(ks[5], (DEPTH, 6 * D_MODEL), 0.01),
        'w_in': nrm(ks[6], (DEPTH, D_MODEL, IN_TOTAL), D_MODEL ** -0.5),
        'sink_logit': nrm(ks[7], (DEPTH, A_Q_HEADS), 0.5),
        'lam_q1': nrm(ks[8], (DEPTH, B_DIM), 0.1),
        'lam_k1': nrm(ks[9], (DEPTH, B_DIM), 0.1),
        'lam_q2': nrm(ks[10], (DEPTH, B_DIM), 0.1),
        'lam_k2': nrm(ks[11], (DEPTH, B_DIM), 0.1),
        'subln_w': 1.0 + nrm(ks[12], (DEPTH, 2 * B_DIM), 0.02),
        'w_a': nrm(ks[13], (DEPTH, A_OUT, D_MODEL), BETA * A_OUT ** -0.5),
        'w_b': nrm(ks[14], (DEPTH, B_OUT, D_MODEL), BETA * B_OUT ** -0.5),
        'w_o': nrm(ks[15], (DEPTH, D_MODEL, D_MODEL), BETA * D_MODEL ** -0.5),
        'ln1_g': 1.0 + nrm(ks[16], (DEPTH, D_MODEL), 0.02),
        'ln1_b': nrm(ks[17], (DEPTH, D_MODEL), 0.02),
        'w_gu': nrm(ks[18], (DEPTH, D_MODEL, 2 * D_FF), D_MODEL ** -0.5),
        'w_down': nrm(ks[19], (DEPTH, D_FF, D_MODEL), BETA * D_FF ** -0.5),
        'ln2_g': 1.0 + nrm(ks[20], (DEPTH, D_MODEL), 0.02),
        'ln2_b': nrm(ks[21], (DEPTH, D_MODEL), 0.02),
    }


def reference(x_prompt, x_sample, c_prompt, c_sample, w_ada, b_ada, w_in, sink_logit, lam_q1, lam_k1, lam_q2, lam_k2, subln_w, w_a, w_b, w_o, ln1_g, ln1_b, w_gu, w_down, ln2_g, ln2_b):
    y_prompt = run_trunk(x_prompt, c_prompt, w_ada, b_ada, w_in, sink_logit, lam_q1, lam_k1, lam_q2, lam_k2, subln_w, w_a, w_b, w_o, ln1_g, ln1_b, w_gu, w_down, ln2_g, ln2_b)
    y_sample = run_trunk(x_sample, c_sample, w_ada, b_ada, w_in, sink_logit, lam_q1, lam_k1, lam_q2, lam_k2, subln_w, w_a, w_b, w_o, ln1_g, ln1_b, w_gu, w_down, ln2_g, ln2_b)
    return (y_prompt, y_sample)
```

```cpp
#include <hip/hip_runtime.h>
#include <hip/hip_cooperative_groups.h>
#include <cstdio>
#include <cstdint>
namespace cg = cooperative_groups;
namespace pg8 {
#define PG8_LAS __attribute__((address_space(3)))
typedef unsigned short bf16_t;
typedef short bf16x8 __attribute__((ext_vector_type(8)));
typedef float f32x4 __attribute__((ext_vector_type(4)));
typedef unsigned u32x4 __attribute__((ext_vector_type(4)));
constexpr int BM = 256, BK = 64, HALF = 128, HTB = HALF * BK * 2  , STAGE_BYTES = 8 * HTB, NXCD = 8, WGM = 4;

__host__ __device__ __forceinline__ int lds_byte(int r, int c) { const int st = (r >> 4) * 2 + (c >> 5), rr = r & 15, cc = c & 31, ob = rr * 64 + cc * 2; return st * 1024 + (ob ^ (((ob >> 9) & 1) << 5)); }
__host__ __device__ __forceinline__ void stage_rc(int b, int& R, int& C) { const int st = b / 1024, sb = b % 1024, swz = sb ^ (((sb >> 9) & 1) << 5); R = (st >> 1) * 16 + swz / 64; C = (st & 1) * 32 + (swz % 64) / 2; }
__host__ __device__ __forceinline__ int perm32(int rho) { const int n = rho >> 4, i = rho & 15; return 8 * (i >> 2) + 4 * n + (i & 3); }

struct Unit { int pm, pn; };
struct Gemm { const bf16_t* A; const bf16_t* Bt; int M, N, K; };

struct StaticOrder {
    int nM, nN, nwg, G, c;
    __host__ __device__ void init(int M, int N, int G_, int c_) { nM = M / BM; nN = N / BM; nwg = nM * nN; G = G_; c = c_; }
    __host__ __device__ bool next(int i, Unit& u) const {
        const long L = (long)i * G + c; if (L >= nwg) return false;
        int wgid = (int)L; { const int q = nwg / NXCD, r = nwg % NXCD, xcd = wgid % NXCD, off = wgid / NXCD; wgid = (xcd < r ? xcd * (q + 1) : r * (q + 1) + (xcd - r) * q) + off; }
        const int nig = WGM * nN, gid = wgid / nig, fm = gid * WGM, gsz = (nM - fm) < WGM ? (nM - fm) : WGM;
        u.pm = fm + ((wgid % nig) % gsz); u.pn = (wgid % nig) / gsz; return true;
    }
    __device__ __forceinline__ void a_ready(const Unit&) const {}
    __device__ __forceinline__ void done(const Unit&) const {}
};

__device__ __forceinline__ unsigned cvt_pk_bf16(float lo, float hi) { unsigned r; asm volatile("v_cvt_pk_bf16_f32 %0, %1, %2" : "=v"(r) : "v"(lo), "v"(hi)); return r; }
typedef float f32x2 __attribute__((ext_vector_type(2)));
template <class Epi, class Sched, bool ALIGN_EPI = false, bool SP2 = false>
__device__ __forceinline__ void gemm_phase(PG8_LAS unsigned char* lds, const Gemm g, const Sched& S, const Epi& E) {
    int tid_l = threadIdx.x; asm volatile("" : "+v"(tid_l));
    const int tid = tid_l, wid = __builtin_amdgcn_readfirstlane(tid >> 6), lane = tid & 63, wr = wid >> 2, wc = wid & 3, fr = lane & 15, fq = lane >> 4;
    const int K = g.K, nt = K / BK;
    unsigned voffA[2], voffB[2];
#pragma unroll
    for (int i = 0; i < 2; ++i) { int R, C; stage_rc(tid * 16 + i * 8192, R, C); const int Rb = Epi::PERM ? ((R & ~31) + perm32(R & 31)) : R;
        voffA[i] = (unsigned)(R * K + C) * 2u; voffB[i] = (unsigned)(Rb * K + C) * 2u; }
    const size_t kstep = (size_t)(BK * 2);
    const size_t hstep = (size_t)HALF * K * 2;
    const size_t tstep = 2 * hstep;
    const unsigned ldsw = (unsigned)wid * 1024u;
    const int aoff = lds_byte(wr * 64 + fr, fq * 8), boff = lds_byte(wc * 32 + fr, fq * 8);
#define PG8_SA(b, h) (((b) * 2 + (h)) * HTB)
#define PG8_SB(b, h) ((4 + (b) * 2 + (h)) * HTB)
#define PG8_STAGE(bufoff, gbase, voff) do { _Pragma("unroll") for (int _i = 0; _i < 2; ++_i) \
        __builtin_amdgcn_global_load_lds((const unsigned*)((const char*)(gbase) + (voff)[_i]), (PG8_LAS unsigned*)(lds + (bufoff) + ldsw + _i * 8192), 16, 0, 0); } while (0)
#define PG8_LDA(dst, b, h) do { _Pragma("unroll") for (int m = 0; m < 4; ++m) _Pragma("unroll") for (int k = 0; k < 2; ++k) dst[m][k] = *(const PG8_LAS bf16x8*)(lds + PG8_SA(b, h) + aoff + m * 2048 + k * 1024); } while (0)
#define PG8_LDB(dst, b, h) do { _Pragma("unroll") for (int n = 0; n < 2; ++n) _Pragma("unroll") for (int k = 0; k < 2; ++k) dst[n][k] = *(const PG8_LAS bf16x8*)(lds + PG8_SB(b, h) + boff + n * 2048 + k * 1024); } while (0)
#define PG8_MMA(ai, bj, At, Bt) do { __builtin_amdgcn_s_setprio(1); _Pragma("unroll") for (int m = 0; m < 4; ++m) _Pragma("unroll") for (int n = 0; n < 2; ++n) _Pragma("unroll") for (int k = 0; k < 2; ++k) \
        acc[ai][bj][m][n] = __builtin_amdgcn_mfma_f32_16x16x32_bf16(Bt[n][k], At[m][k], acc[ai][bj][m][n], 0, 0, 0); __builtin_amdgcn_s_setprio(0); } while (0)
#define PG8_WAIT_V(n) asm volatile("s_waitcnt vmcnt(" #n ")" ::: "memory")
#define PG8_WAIT_L(n) asm volatile("s_waitcnt lgkmcnt(" #n ")" ::: "memory")
#define PG8_BAR __builtin_amdgcn_s_barrier()
#define PG8_SCHED __builtin_amdgcn_sched_barrier(0)
    Unit cur, nxt; int ui = 0;
    if (!S.next(0, cur)) return;
    f32x4 acc[2][2][4][2];
#pragma unroll
    for (int a = 0; a < 2; ++a)
#pragma unroll
        for (int b = 0; b < 2; ++b)
#pragma unroll
            for (int m = 0; m < 4; ++m)
#pragma unroll
                for (int n = 0; n < 2; ++n) acc[a][b][m][n] = (f32x4){0.f, 0.f, 0.f, 0.f};
    bf16x8 At[4][2], B0[2][2], B1[2][2];
    const char* cA = (const char*)g.A + (size_t)cur.pm * tstep; const char* cB = (const char*)g.Bt + (size_t)cur.pn * tstep;
    S.a_ready(cur);
    if constexpr (SP2) {
        PG8_STAGE(PG8_SB(0, 0), cB, voffB); PG8_STAGE(PG8_SB(0, 1), cB + hstep, voffB); PG8_STAGE(PG8_SA(0, 0), cA, voffA); PG8_STAGE(PG8_SA(0, 1), cA + hstep, voffA);
        if (wr == 1) PG8_BAR;
        PG8_WAIT_V(2); PG8_BAR;
        PG8_STAGE(PG8_SB(1, 0), cB + kstep, voffB); PG8_STAGE(PG8_SA(1, 0), cA + kstep, voffA); PG8_STAGE(PG8_SB(1, 1), cB + hstep + kstep, voffB);
        PG8_WAIT_V(6); PG8_BAR;
    } else {
        PG8_STAGE(PG8_SB(0, 0), cB, voffB); PG8_STAGE(PG8_SA(0, 0), cA, voffA); PG8_STAGE(PG8_SB(0, 1), cB + hstep, voffB); PG8_STAGE(PG8_SA(0, 1), cA + hstep, voffA);
        if (wr == 1) PG8_BAR;
        PG8_WAIT_V(4); PG8_BAR;
        PG8_STAGE(PG8_SB(1, 0), cB + kstep, voffB); PG8_STAGE(PG8_SA(1, 0), cA + kstep, voffA); PG8_STAGE(PG8_SB(1, 1), cB + hstep + kstep, voffB);
        PG8_WAIT_V(6); PG8_BAR;
    }
    for (;;) {
        const bool has_next = S.next(ui + 1, nxt);
        const char* nA = has_next ? (const char*)g.A + (size_t)nxt.pm * tstep : cA; const char* nB = has_next ? (const char*)g.Bt + (size_t)nxt.pn * tstep : cB;
        for (int t = 0; t < nt; t += 2) {
            if constexpr (Epi::HAS_MID) { if (t == (nt >> 1)) E.mid(acc, cur, wr, wc, fr, fq); }
            const bool last = (t == nt - 2);
            const char* a1 = cA + (size_t)(t + 1) * kstep;
            const char* a2 = last ? nA : cA + (size_t)(t + 2) * kstep; const char* b2 = last ? nB : cB + (size_t)(t + 2) * kstep;
            const char* a3 = a2 + kstep; const char* b3 = b2 + kstep;
            if (last && has_next) S.a_ready(nxt);
            if constexpr (SP2) {
            PG8_LDB(B0, 0, 0); PG8_LDB(B1, 0, 1); PG8_SCHED; PG8_LDA(At, 0, 0); PG8_STAGE(PG8_SA(1, 1), a1 + hstep, voffA);
            PG8_WAIT_V(8); PG8_WAIT_L(0); PG8_BAR; PG8_MMA(0, 0, At, B0); PG8_MMA(0, 1, At, B1); PG8_BAR; PG8_SCHED;
            PG8_LDA(At, 0, 1); PG8_STAGE(PG8_SB(0, 0), b2, voffB); PG8_STAGE(PG8_SB(0, 1), b2 + hstep, voffB); PG8_STAGE(PG8_SA(0, 0), a2, voffA);
            PG8_WAIT_V(8); PG8_WAIT_L(0); PG8_BAR; PG8_MMA(1, 0, At, B0); PG8_MMA(1, 1, At, B1); PG8_BAR; PG8_SCHED;
            PG8_LDB(B0, 1, 0); PG8_LDB(B1, 1, 1); PG8_SCHED; PG8_LDA(At, 1, 0); PG8_STAGE(PG8_SA(0, 1), a2 + hstep, voffA);
            PG8_WAIT_V(8); PG8_WAIT_L(0); PG8_BAR; PG8_MMA(0, 0, At, B0); PG8_MMA(0, 1, At, B1); PG8_BAR; PG8_SCHED;
            PG8_LDA(At, 1, 1); PG8_STAGE(PG8_SB(1, 0), b3, voffB); PG8_STAGE(PG8_SB(1, 1), b3 + hstep, voffB); PG8_STAGE(PG8_SA(1, 0), a3, voffA);
            PG8_WAIT_V(8); PG8_WAIT_L(0); PG8_BAR; PG8_MMA(1, 0, At, B0); PG8_MMA(1, 1, At, B1); PG8_BAR; PG8_SCHED;
            } else {
            PG8_LDB(B0, 0, 0); PG8_SCHED; PG8_LDA(At, 0, 0); PG8_STAGE(PG8_SA(1, 1), a1 + hstep, voffA);
            PG8_WAIT_L(8); PG8_BAR; PG8_WAIT_L(0); PG8_MMA(0, 0, At, B0); PG8_BAR; PG8_SCHED;
            PG8_LDB(B1, 0, 1); PG8_STAGE(PG8_SB(0, 0), b2, voffB);
            PG8_BAR; PG8_WAIT_L(0); PG8_MMA(0, 1, At, B1); PG8_BAR;
            PG8_LDA(At, 0, 1); PG8_STAGE(PG8_SA(0, 0), a2, voffA);
            PG8_BAR; PG8_WAIT_L(0); PG8_MMA(1, 0, At, B0); PG8_BAR; PG8_SCHED;
            PG8_STAGE(PG8_SB(0, 1), b2 + hstep, voffB);
            PG8_WAIT_V(6); PG8_BAR; PG8_MMA(1, 1, At, B1); PG8_BAR;
            PG8_LDB(B0, 1, 0); PG8_SCHED; PG8_LDA(At, 1, 0); PG8_STAGE(PG8_SA(0, 1), a2 + hstep, voffA);
            PG8_WAIT_L(8); PG8_BAR; PG8_WAIT_L(0); PG8_MMA(0, 0, At, B0); PG8_BAR; PG8_SCHED;
            PG8_LDB(B1, 1, 1); PG8_STAGE(PG8_SB(1, 0), b3, voffB);
            PG8_BAR; PG8_WAIT_L(0); PG8_MMA(0, 1, At, B1); PG8_BAR;
            PG8_LDA(At, 1, 1); PG8_STAGE(PG8_SA(1, 0), a3, voffA);
            PG8_BAR; PG8_WAIT_L(0); PG8_MMA(1, 0, At, B0); PG8_BAR; PG8_SCHED;
            PG8_STAGE(PG8_SB(1, 1), b3 + hstep, voffB);
            PG8_WAIT_V(6); PG8_BAR; PG8_MMA(1, 1, At, B1); PG8_BAR;
            }
        }
        if constexpr (ALIGN_EPI) { if (wr == 0) PG8_BAR; }
        if constexpr (!Epi::AFTER_DRAIN) { E(acc, cur, wr, wc, fr, fq);
#ifdef PROBE_EPI_TWICE
            if constexpr (Epi::PERM == (PROBE_EPI_TWICE == 1)) { asm volatile("" ::: "memory"); E(acc, cur, wr, wc, fr, fq); }
#endif
            S.done(cur); }
        if (!has_next) break;
#pragma unroll
        for (int a = 0; a < 2; ++a)
#pragma unroll
            for (int b = 0; b < 2; ++b)
#pragma unroll
                for (int m = 0; m < 4; ++m)
#pragma unroll
                    for (int n = 0; n < 2; ++n) acc[a][b][m][n] = (f32x4){0.f, 0.f, 0.f, 0.f};
        cur = nxt; cA = nA; cB = nB; ++ui;
        if constexpr (ALIGN_EPI) { if (wr == 1) PG8_BAR; }
    }
    PG8_WAIT_V(0);
    if constexpr (!ALIGN_EPI) { if (wr == 0) PG8_BAR; }
    PG8_BAR;
    if constexpr (Epi::AFTER_DRAIN) { E.fused(acc, cur, wr, wc, fr, fq, lds, wid, lane); S.done(cur); }
#undef PG8_SA
#undef PG8_SB
#undef PG8_STAGE
#undef PG8_LDA
#undef PG8_LDB
#undef PG8_MMA
#undef PG8_WAIT_V
#undef PG8_WAIT_L
#undef PG8_BAR
#undef PG8_SCHED
}
}

constexpr int T_TOK = 81920, DM = 1024, NPROJ = 4352, DFF = 2816, SEQ = 4096, NBATCH = 20, PROMPT_TILES = 256  ;
constexpr int MODN = 6 * DM;
constexpr float ALPHA_RES = 1.189207115002721f;
constexpr float LOG2E = 1.4426950408889634f;
constexpr float QSCALE = 0.125f * LOG2E;
constexpr float LN_EPS = 1e-5f;
#define LAS __attribute__((address_space(3)))
typedef unsigned u32x2 __attribute__((ext_vector_type(2)));
typedef _Float16 h16x4 __attribute__((ext_vector_type(4)));
typedef _Float16 h16_t;

__device__ __forceinline__ float bf_lo(unsigned w) { return __uint_as_float(w << 16); }
__device__ __forceinline__ float bf_hi(unsigned w) { return __uint_as_float(w & 0xffff0000u); }
__device__ __forceinline__ float sigmoidf_fast(float v) { return __builtin_amdgcn_rcpf(1.0f + __builtin_amdgcn_exp2f(-v * LOG2E)); }

namespace pg8 {
struct EpiProj {
    static constexpr bool PERM = true, AFTER_DRAIN = false, HAS_MID = false;
    bf16_t* O; const float* cosT; const float* sinT;
    __device__ __forceinline__ void operator()(const f32x4 (&acc)[2][2][4][2], const Unit& u, int wr, int wc, int fr, int fq) const {
        const int row0 = u.pm * BM + wr * 64 + fr;
#pragma unroll
        for (int bj = 0; bj < 2; ++bj) {
            const int c128 = 2 * u.pn + bj;
            const int mode = (c128 < 4 || (c128 >= 6 && c128 < 10)) ? 1 : ((c128 == 4 || (c128 >= 10 && c128 < 14)) ? 2 : (c128 >= 18 ? 3 : 0));
            const int col0 = c128 * 128 + wc * 32 + 8 * fq;
            const int i0 = 16 * (wc & 1) + 4 * fq;
#pragma unroll
            for (int ai = 0; ai < 2; ++ai)
#pragma unroll
                for (int m = 0; m < 4; ++m) {
                    const int row = row0 + ai * HALF + m * 16;
                    f32x4 v0 = acc[ai][bj][m][0], v1 = acc[ai][bj][m][1];
                    if (mode == 1 || mode == 2) {
                        const int pos = row & (SEQ - 1);
                        const f32x4 c = *(const f32x4*)(cosT + pos * 32 + i0), s = *(const f32x4*)(sinT + pos * 32 + i0);
                        f32x4 a, b;
                        a[0] = v0[0] * c[0] - v0[1] * s[0]; a[1] = v0[1] * c[0] + v0[0] * s[0];
                        a[2] = v0[2] * c[1] - v0[3] * s[1]; a[3] = v0[3] * c[1] + v0[2] * s[1];
                        b[0] = v1[0] * c[2] - v1[1] * s[2]; b[1] = v1[1] * c[2] + v1[0] * s[2];
                        b[2] = v1[2] * c[3] - v1[3] * s[3]; b[3] = v1[3] * c[3] + v1[2] * s[3];
                        if (mode == 1) { a = a * QSCALE; b = b * QSCALE; }
                        v0 = a; v1 = b;
                    } else if (mode == 3) {
#pragma unroll
                        for (int j = 0; j < 4; ++j) { v0[j] = sigmoidf_fast(v0[j]); v1[j] = sigmoidf_fast(v1[j]); }
                    }
                    u32x4 w; w.x = cvt_pk_bf16(v0[0], v0[1]); w.y = cvt_pk_bf16(v0[2], v0[3]); w.z = cvt_pk_bf16(v1[0], v1[1]); w.w = cvt_pk_bf16(v1[2], v1[3]);
                    *(u32x4*)(O + (size_t)row * NPROJ + col0) = w;
                }
        }
    }
};
struct EpiMerge {
    static constexpr bool PERM = true, AFTER_DRAIN = false, HAS_MID = true;
    const bf16_t* proj; bf16_t* O;
    __device__ __forceinline__ void mid(f32x4 (&acc)[2][2][4][2], const Unit& u, int wr, int wc, int fr, int fq) const {
        int row0 = u.pm * BM + wr * 64 + fr;
        asm volatile("" : "+v"(row0));
#pragma unroll
        for (int ai = 0; ai < 2; ++ai)
#pragma unroll
            for (int m = 0; m < 4; ++m)
#pragma unroll
                for (int bj = 0; bj < 2; ++bj) {
                    const size_t off = (size_t)(row0 + ai * HALF + m * 16) * NPROJ + 2304 + u.pn * BM + bj * HALF + wc * 32 + 8 * fq;
                    const u32x4 ga = *(const u32x4*)(proj + off), gb = *(const u32x4*)(proj + off + 1024);
                    f32x4 r0, r1;
                    r0[0] = bf_lo(ga.x) * __builtin_amdgcn_rcpf(bf_lo(gb.x)); r0[1] = bf_hi(ga.x) * __builtin_amdgcn_rcpf(bf_hi(gb.x));
                    r0[2] = bf_lo(ga.y) * __builtin_amdgcn_rcpf(bf_lo(gb.y)); r0[3] = bf_hi(ga.y) * __builtin_amdgcn_rcpf(bf_hi(gb.y));
                    r1[0] = bf_lo(ga.z) * __builtin_amdgcn_rcpf(bf_lo(gb.z)); r1[1] = bf_hi(ga.z) * __builtin_amdgcn_rcpf(bf_hi(gb.z));
                    r1[2] = bf_lo(ga.w) * __builtin_amdgcn_rcpf(bf_lo(gb.w)); r1[3] = bf_hi(ga.w) * __builtin_amdgcn_rcpf(bf_hi(gb.w));
                    acc[ai][bj][m][0] = acc[ai][bj][m][0] * r0; acc[ai][bj][m][1] = acc[ai][bj][m][1] * r1;
                    if (bj == 1 && (m & 1)) asm volatile("" : "+v"(acc[ai][bj][m][0]), "+v"(acc[ai][bj][m][1]) :: "memory");
                }
    }
    __device__ __forceinline__ void operator()(const f32x4 (&acc)[2][2][4][2], const Unit& u, int wr, int wc, int fr, int fq) const {
        const int row0 = u.pm * BM + wr * 64 + fr;
#pragma unroll
        for (int ai = 0; ai < 2; ++ai)
#pragma unroll
            for (int m = 0; m < 4; ++m)
#pragma unroll
                for (int bj = 0; bj < 2; ++bj) {
                    const int row = row0 + ai * HALF + m * 16, col0 = u.pn * BM + bj * HALF + wc * 32 + 8 * fq;
                    const u32x4 gb = *(const u32x4*)(proj + (size_t)row * NPROJ + 3328 + col0);
                    const f32x4 a = acc[ai][bj][m][0], b = acc[ai][bj][m][1];
                    u32x4 w;
                    w.x = cvt_pk_bf16(a[0] * bf_lo(gb.x), a[1] * bf_hi(gb.x)); w.y = cvt_pk_bf16(a[2] * bf_lo(gb.y), a[3] * bf_hi(gb.y));
                    w.z = cvt_pk_bf16(b[0] * bf_lo(gb.z), b[1] * bf_hi(gb.z)); w.w = cvt_pk_bf16(b[2] * bf_lo(gb.w), b[3] * bf_hi(gb.w));
                    *(u32x4*)(O + (size_t)row * DM + col0) = w;
                    if (bj == 1 && (m & 1)) asm volatile("" ::: "memory");
                }
    }
};
struct EpiWo {
    static constexpr bool PERM = false, AFTER_DRAIN = false, HAS_MID = false;
    const float* xp; const float* xs; const float* mod; const float* bada; h16_t* Y;
    __device__ __forceinline__ void operator()(const f32x4 (&acc)[2][2][4][2], const Unit& u, int wr, int wc, int fr, int fq) const {
        const int b = u.pm >> 4;
        const float* xbase = (u.pm < PROMPT_TILES) ? xp + (size_t)u.pm * BM * DM : xs + (size_t)(u.pm - PROMPT_TILES) * BM * DM;
        h16_t* ybase = Y + (size_t)u.pm * BM * DM;
#pragma unroll
        for (int bj = 0; bj < 2; ++bj)
#pragma unroll
            for (int n = 0; n < 2; ++n) {
                const int col = u.pn * BM + bj * HALF + wc * 32 + n * 16 + 4 * fq;
                const f32x4 gate = *(const f32x4*)(mod + b * MODN + 2 * DM + col) + *(const f32x4*)(bada + 2 * DM + col);
#pragma unroll
                for (int ai = 0; ai < 2; ++ai)
#pragma unroll
                    for (int m = 0; m < 4; ++m) {
                        const size_t off = (size_t)(ai * HALF + wr * 64 + m * 16 + fr) * DM + col;
                        const f32x4 xv = *(const f32x4*)(xbase + off);
                        *(h16x4*)(ybase + off) = __builtin_convertvector(xv * ALPHA_RES + gate * acc[ai][bj][m][n], h16x4);
                    }
            }
    }
};
struct EpiGU {
    static constexpr bool PERM = true, AFTER_DRAIN = false, HAS_MID = false;
    bf16_t* Hd;
    __device__ __forceinline__ void operator()(const f32x4 (&acc)[2][2][4][2], const Unit& u, int wr, int wc, int fr, int fq) const {
        const int row0 = u.pm * BM + wr * 64 + fr, hcol = u.pn * HALF + wc * 32 + 8 * fq;
#pragma unroll
        for (int ai = 0; ai < 2; ++ai)
#pragma unroll
            for (int m = 0; m < 4; ++m) {
                const int row = row0 + ai * HALF + m * 16;
                float a[8];
#pragma unroll
                for (int n = 0; n < 2; ++n)
#pragma unroll
                    for (int j = 0; j < 4; ++j) { const float g = acc[ai][0][m][n][j]; a[4 * n + j] = g * acc[ai][1][m][n][j] * sigmoidf_fast(g); }
                u32x4 w; w.x = cvt_pk_bf16(a[0], a[1]); w.y = cvt_pk_bf16(a[2], a[3]); w.z = cvt_pk_bf16(a[4], a[5]); w.w = cvt_pk_bf16(a[6], a[7]);
                *(u32x4*)(Hd + (size_t)row * DFF + hcol) = w;
            }
    }
};
struct EpiDown {
    static constexpr bool PERM = false, AFTER_DRAIN = false, HAS_MID = false;
    const h16_t* Y; h16_t* Z; const f32x2* st1; const float* mod; const float* bada; const float* g1; const float* b1;
    __device__ __forceinline__ void operator()(const f32x4 (&acc)[2][2][4][2], const Unit& u, int wr, int wc, int fr, int fq) const {
        const int b = u.pm >> 4;
        h16_t* zbase = Z + (size_t)u.pm * BM * DM; const h16_t* ybase = Y + (size_t)u.pm * BM * DM;
        const f32x2* sb = st1 + (size_t)u.pm * BM;
#pragma unroll
        for (int bj = 0; bj < 2; ++bj)
#pragma unroll
            for (int n = 0; n < 2; ++n) {
                const int col = u.pn * BM + bj * HALF + wc * 32 + n * 16 + 4 * fq;
                const f32x4 gate = *(const f32x4*)(mod + b * MODN + 5 * DM + col) + *(const f32x4*)(bada + 5 * DM + col);
                const f32x4 gv = *(const f32x4*)(g1 + col) * ALPHA_RES, bv = *(const f32x4*)(b1 + col) * ALPHA_RES;
#pragma unroll
                for (int ai = 0; ai < 2; ++ai)
#pragma unroll
                    for (int m = 0; m < 4; ++m) {
                        const int r = ai * HALF + wr * 64 + m * 16 + fr;
                        const f32x2 st = sb[r];
                        const size_t off = (size_t)r * DM + col;
                        const f32x4 yv = __builtin_convertvector(*(const h16x4*)(ybase + off), f32x4);
                        *(h16x4*)(zbase + off) = __builtin_convertvector((yv - st.x) * st.y * gv + bv + gate * acc[ai][bj][m][n], h16x4);
                    }
            }
    }
};
}

namespace att {
using pg8::bf16_t;
typedef short bf16x8 __attribute__((ext_vector_type(8)));
typedef short s16x4 __attribute__((ext_vector_type(4)));
typedef float f32x16 __attribute__((ext_vector_type(16)));
typedef float f32x4 __attribute__((ext_vector_type(4)));
typedef unsigned u32x4 __attribute__((ext_vector_type(4)));
constexpr int KP = 144;
constexpr int KBUF = 64 * KP;
constexpr int OFF_V = 2 * KBUF;
constexpr int VBUF_MAX = 64 * (128 * 2 + 64);
constexpr int OFF_FLAG = OFF_V + 3 * VBUF_MAX;
constexpr int OFF_ST = 0;
constexpr int STP = 272;
constexpr int ST_W = 32 * STP;
constexpr int ATT_LDS = OFF_FLAG + 16;
static_assert(8 * ST_W <= OFF_FLAG, "staging fits under the flag word");
__device__ __forceinline__ int crow(int r, int hi) { return (r & 3) + 8 * (r >> 2) + 4 * hi; }
__device__ __forceinline__ s16x4 vtr(LAS const char* p) { return __builtin_bit_cast(s16x4, __builtin_amdgcn_ds_read_tr16_b64_v4i16((LAS s16x4*)p)); }
__device__ __forceinline__ unsigned cvtpk(float lo, float hi) { return pg8::cvt_pk_bf16(lo, hi); }

template <int DV, bool WIN>
__device__ __forceinline__ void flash_robust(LAS char* lds, const bf16_t* Qrow, const bf16_t* Kg, const bf16_t* Vg, int t0, int t1, int qpos,
                                           float m_init, float l_init, bool first, f32x16 (&o)[DV / 32], float& l_out) {
    int tid_l = threadIdx.x; asm volatile("" : "+v"(tid_l)); const int tid = tid_l, lane = tid & 63, r32 = lane & 31, hi = lane >> 5;
    constexpr int VP = DV * 2 + 64, VBUF = 64 * VP, NVC = DV / 64;
    bf16x8 qf[4];
#pragma unroll
    for (int d0 = 0; d0 < 4; ++d0) qf[d0] = *(const bf16x8*)(Qrow + d0 * 16 + hi * 8);
    const int krow = tid >> 3, kch = tid & 7;
    const bf16_t* kg = Kg + (size_t)krow * NPROJ + kch * 8;
    const int kl = krow * KP + kch * 16;
    const int vrow = (DV == 128) ? (tid >> 4) : (tid >> 3), vch = (DV == 128) ? (tid & 15) : (tid & 7);
    const bf16_t* vg = Vg + (size_t)vrow * NPROJ + vch * 8;
    const int vl = OFF_V + vrow * VP + vch * 16;
    u32x4 kreg, vreg[NVC];
    kreg = *(const u32x4*)(kg + (size_t)t0 * 64 * NPROJ);
#pragma unroll
    for (int i = 0; i < NVC; ++i) vreg[i] = *(const u32x4*)(vg + (size_t)(t0 * 64 + 32 * i) * NPROJ);
    __syncthreads();
    *(LAS u32x4*)(lds + kl) = kreg;
#pragma unroll
    for (int i = 0; i < NVC; ++i) *(LAS u32x4*)(lds + vl + i * 32 * VP) = vreg[i];
    __syncthreads();
    float mref = m_init, lsum = (hi == 0) ? l_init : 0.f;
#pragma unroll
    for (int blk = 0; blk < DV / 32; ++blk)
#pragma unroll
        for (int r = 0; r < 16; ++r) o[blk][r] = 0.f;
    const int kaddr = r32 * KP + hi * 16;
    const int vaddr = OFF_V + (4 * hi + ((lane & 15) >> 2)) * VP + (16 * ((lane >> 4) & 1) + 4 * (lane & 3)) * 2;
    for (int t = t0; t < t1; ++t) {
        const int cur = (t - t0) & 1;
        const bool more = (t + 1 < t1);
        if (more) {
            kreg = *(const u32x4*)(kg + (size_t)(t + 1) * 64 * NPROJ);
#pragma unroll
            for (int i = 0; i < NVC; ++i) vreg[i] = *(const u32x4*)(vg + (size_t)((t + 1) * 64 + 32 * i) * NPROJ);
        }
        LAS const char* Kc = lds + cur * KBUF + kaddr;
        LAS const char* Vc = lds + cur * VBUF + vaddr;
        f32x16 p0, p1;
#pragma unroll
        for (int r = 0; r < 16; ++r) { p0[r] = -mref; p1[r] = -mref; }
#pragma unroll
        for (int d0 = 0; d0 < 4; ++d0) {
            const bf16x8 k0 = *(LAS const bf16x8*)(Kc + d0 * 32), k1 = *(LAS const bf16x8*)(Kc + d0 * 32 + 32 * KP);
            p0 = __builtin_amdgcn_mfma_f32_32x32x16_bf16(k0, qf[d0], p0, 0, 0, 0);
            p1 = __builtin_amdgcn_mfma_f32_32x32x16_bf16(k1, qf[d0], p1, 0, 0, 0);
        }
        if (WIN) {
            const int kb = 64 * t + 4 * hi - qpos;
#pragma unroll
            for (int r = 0; r < 16; ++r) {
                const int d = kb + (r & 3) + 8 * (r >> 2);
                if (d > 128 || d < -128) p0[r] = -1e30f;
                if (d + 32 > 128 || d + 32 < -128) p1[r] = -1e30f;
            }
        }
        float rm = fmaxf(p0[0], p1[0]);
#pragma unroll
        for (int r = 1; r < 16; ++r) rm = fmaxf(rm, fmaxf(p0[r], p1[r]));
        rm = fmaxf(rm, __shfl_xor(rm, 32));
        if (first || __any(rm > 8.0f)) {
            const float dl = first ? rm : fmaxf(rm, 0.f);
            mref += dl;
#pragma unroll
            for (int r = 0; r < 16; ++r) { p0[r] -= dl; p1[r] -= dl; }
            if (!first) {
                const float al = __builtin_amdgcn_exp2f(-dl);
                lsum *= al;
#pragma unroll
                for (int blk = 0; blk < DV / 32; ++blk)
#pragma unroll
                    for (int r = 0; r < 16; ++r) o[blk][r] *= al;
            }
            first = false;
        }
        float s0 = 0.f, s1 = 0.f;
#pragma unroll
        for (int r = 0; r < 16; ++r) { p0[r] = __builtin_amdgcn_exp2f(p0[r]); p1[r] = __builtin_amdgcn_exp2f(p1[r]); s0 += p0[r]; s1 += p1[r]; }
        lsum += s0 + s1;
        bf16x8 pk[4];
        __builtin_amdgcn_sched_barrier(0);
#pragma unroll
        for (int c = 0; c < 2; ++c) {
            u32x4 w0, w1;
            w0.x = cvtpk(p0[8 * c + 0], p0[8 * c + 1]); w0.y = cvtpk(p0[8 * c + 2], p0[8 * c + 3]); w0.z = cvtpk(p0[8 * c + 4], p0[8 * c + 5]); w0.w = cvtpk(p0[8 * c + 6], p0[8 * c + 7]);
            w1.x = cvtpk(p1[8 * c + 0], p1[8 * c + 1]); w1.y = cvtpk(p1[8 * c + 2], p1[8 * c + 3]); w1.z = cvtpk(p1[8 * c + 4], p1[8 * c + 5]); w1.w = cvtpk(p1[8 * c + 6], p1[8 * c + 7]);
            pk[c] = __builtin_bit_cast(bf16x8, w0); pk[2 + c] = __builtin_bit_cast(bf16x8, w1);
        }
#pragma unroll
        for (int blk = 0; blk < DV / 32; ++blk)
#pragma unroll
            for (int c = 0; c < 4; ++c) {
                const s16x4 lo = vtr(Vc + c * 16 * VP + blk * 64), hh = vtr(Vc + c * 16 * VP + 8 * VP + blk * 64);
                const bf16x8 vf = (bf16x8){lo[0], lo[1], lo[2], lo[3], hh[0], hh[1], hh[2], hh[3]};
                o[blk] = __builtin_amdgcn_mfma_f32_32x32x16_bf16(vf, pk[c], o[blk], 0, 0, 0);
                if (c == 3) __builtin_amdgcn_sched_barrier(0);
            }
        if (more) {
            *(LAS u32x4*)(lds + (cur ^ 1) * KBUF + kl) = kreg;
#pragma unroll
            for (int i = 0; i < NVC; ++i) *(LAS u32x4*)(lds + (cur ^ 1) * VBUF + vl + i * 32 * VP) = vreg[i];
        }
        __syncthreads();
    }
    l_out = lsum + __shfl_xor(lsum, 32);
}

__device__ __forceinline__ float halfswap_add(float v) { auto rr = __builtin_amdgcn_permlane32_swap(__float_as_uint(v), __float_as_uint(v), false, false); return __uint_as_float(rr[0]) + __uint_as_float(rr[1]); }
template <int DV, bool WIN>
__device__ __forceinline__ void flash_fast(LAS char* lds, const bf16_t* Qrow, const bf16_t* Kg, const bf16_t* Vg, int t0, int t1, int qpos,
                                           float l_init, f32x16 (&o)[DV / 32], float& l_out) {
    int tid_l = threadIdx.x; asm volatile("" : "+v"(tid_l)); const int tid = tid_l, lane = tid & 63, r32 = lane & 31, hi = lane >> 5;
    constexpr int VP = DV * 2 + 64, VBUF = 64 * VP, NVC = DV / 64;
    bf16x8 qf[4];
#pragma unroll
    for (int d0 = 0; d0 < 4; ++d0) qf[d0] = *(const bf16x8*)(Qrow + d0 * 16 + hi * 8);
    const int krow = tid >> 3, kch = tid & 7;
    const bf16_t* kg = Kg + (size_t)krow * NPROJ + kch * 8;
    const int kl = krow * KP + kch * 16;
    const int vrow = (DV == 128) ? (tid >> 4) : (tid >> 3), vch = (DV == 128) ? (tid & 15) : (tid & 7);
    const bf16_t* vg = Vg + (size_t)vrow * NPROJ + vch * 8;
    const int vl = OFF_V + vrow * VP + vch * 16;
    const int kaddr = r32 * KP + hi * 16;
    const int vaddr = OFF_V + (4 * hi + ((lane & 15) >> 2)) * VP + (16 * ((lane >> 4) & 1) + 4 * (lane & 3)) * 2;
    u32x4 kreg, vreg[NVC];
    {
        const int tn = (t0 + 1 < t1) ? t0 + 1 : t0;
        kreg = *(const u32x4*)(kg + (size_t)t0 * 64 * NPROJ);
        const u32x4 k2 = *(const u32x4*)(kg + (size_t)tn * 64 * NPROJ);
#pragma unroll
        for (int i = 0; i < NVC; ++i) vreg[i] = *(const u32x4*)(vg + (size_t)(t0 * 64 + 32 * i) * NPROJ);
        __syncthreads();
        *(LAS u32x4*)(lds + kl) = kreg; *(LAS u32x4*)(lds + KBUF + kl) = k2;
#pragma unroll
        for (int i = 0; i < NVC; ++i) *(LAS u32x4*)(lds + vl + i * 32 * VP) = vreg[i];
        __syncthreads();
    }
    f32x16 sc0, sc1;
    const f32x16 zero16 = {0.f, 0.f, 0.f, 0.f, 0.f, 0.f, 0.f, 0.f, 0.f, 0.f, 0.f, 0.f, 0.f, 0.f, 0.f, 0.f};
#define ATT_QK(S0, S1, KOFF) do { \
        _Pragma("unroll") for (int d0 = 0; d0 < 4; ++d0) { \
            const bf16x8 k0_ = *(LAS const bf16x8*)(lds + (KOFF) + kaddr + d0 * 32), k1_ = *(LAS const bf16x8*)(lds + (KOFF) + kaddr + d0 * 32 + 32 * KP); \
            if (d0 == 0) { S0 = __builtin_amdgcn_mfma_f32_32x32x16_bf16(k0_, qf[0], zero16, 0, 0, 0); S1 = __builtin_amdgcn_mfma_f32_32x32x16_bf16(k1_, qf[0], zero16, 0, 0, 0); } \
            else { S0 = __builtin_amdgcn_mfma_f32_32x32x16_bf16(k0_, qf[d0], S0, 0, 0, 0); S1 = __builtin_amdgcn_mfma_f32_32x32x16_bf16(k1_, qf[d0], S1, 0, 0, 0); } } } while (0)
#define ATT_MASK(S0, S1, T) do { if (WIN) { const int kb_ = 64 * (T) + 4 * hi - qpos + 128; \
        _Pragma("unroll") for (int r = 0; r < 16; ++r) { const int d_ = kb_ + (r & 3) + 8 * (r >> 2); \
            if ((unsigned)d_ > 256u) S0[r] = -1e30f; if ((unsigned)(d_ + 32) > 256u) S1[r] = -1e30f; } } } while (0)
    ATT_QK(sc0, sc1, 0);
    __syncthreads();
#pragma unroll
    for (int blk = 0; blk < DV / 32; ++blk) o[blk] = zero16;
    u32x4 pp[4] = {{0u, 0u, 0u, 0u}, {0u, 0u, 0u, 0u}, {0u, 0u, 0u, 0u}, {0u, 0u, 0u, 0u}};
    float lsum = (hi == 0) ? l_init : 0.f;
    int kn = KBUF;
    int vp_ = 0, vc_ = 0, vn_ = VBUF;
    u32x4 kreg2, vreg2[NVC];
    { const int tk0 = (t0 + 2 < t1) ? t0 + 2 : t1 - 1, tv0 = (t0 + 1 < t1) ? t0 + 1 : t1 - 1;
      kreg2 = *(const u32x4*)(kg + (size_t)tk0 * 64 * NPROJ);
#pragma unroll
      for (int i = 0; i < NVC; ++i) vreg2[i] = *(const u32x4*)(vg + (size_t)(tv0 * 64 + 32 * i) * NPROJ); }
    f32x16 sd0, sd1;
    constexpr int NB = DV / 32, NSL = 4 * NB, EPS = 32 / NSL;
    s16x4 vfr[8]; bf16x8 kf[4];
#pragma unroll
    for (int j = 0; j < 8; ++j) vfr[j] = vtr(lds + vp_ + vaddr + (j >> 1) * 16 * VP + (j & 1) * 8 * VP);
#define ATT_SV(S0, S1, i) ((i) < 16 ? S0[(i) & 15] : S1[(i) & 15])
#define ATT_VF(s) ((bf16x8){vfr[(2 * (s)) & 7][0], vfr[(2 * (s)) & 7][1], vfr[(2 * (s)) & 7][2], vfr[(2 * (s)) & 7][3], vfr[(2 * (s) + 1) & 7][0], vfr[(2 * (s) + 1) & 7][1], vfr[(2 * (s) + 1) & 7][2], vfr[(2 * (s) + 1) & 7][3]})
#define ATT_STEP(SC0, SC1, SN0, SN1, T, KLD, VLD, KST, VST) do { \
        const int tk_ = ((T) + 3 < t1) ? (T) + 3 : t1 - 1, tv_ = ((T) + 2 < t1) ? (T) + 2 : t1 - 1; \
        ATT_MASK(SC0, SC1, (T)); \
        KLD = *(const u32x4*)(kg + (size_t)tk_ * 64 * NPROJ);     \
        _Pragma("unroll") for (int i = 0; i < NVC; ++i) VLD[i] = *(const u32x4*)(vg + (size_t)(tv_ * 64 + 32 * i) * NPROJ); \
        __builtin_amdgcn_sched_barrier(0); \
        _Pragma("unroll") for (int s_ = 0; s_ < NSL; ++s_) { \
            const int blk = s_ >> 2, c = s_ & 3; \
            o[blk] = __builtin_amdgcn_mfma_f32_32x32x16_bf16(ATT_VF(s_), __builtin_bit_cast(bf16x8, pp[c]), o[blk], 0, 0, 0); \
            if (s_ + 4 < NSL) { vfr[(2 * s_) & 7] = vtr(lds + vp_ + vaddr + c * 16 * VP + (blk + 1) * 64); vfr[(2 * s_ + 1) & 7] = vtr(lds + vp_ + vaddr + c * 16 * VP + 8 * VP + (blk + 1) * 64); } \
            else { const int j_ = s_ + 4 - NSL; kf[j_] = *(LAS const bf16x8*)(lds + kn + kaddr + (j_ >> 1) * 32 + (j_ & 1) * 32 * KP); } \
            _Pragma("unroll") for (int e = 0; e < EPS; ++e) { const int i_ = s_ * EPS + e; if (i_ < 16) SC0[i_ & 15] = __builtin_amdgcn_exp2f(SC0[i_ & 15]); else SC1[i_ & 15] = __builtin_amdgcn_exp2f(SC1[i_ & 15]); } \
            if (s_ > 0) { _Pragma("unroll") for (int e = 0; e < EPS; ++e) lsum += ATT_SV(SC0, SC1, (s_ - 1) * EPS + e); } \
            __builtin_amdgcn_sched_barrier(0); } \
        _Pragma("unroll") for (int j = 0; j < 8; ++j) { \
            const int d0 = j >> 1; \
            if ((j & 1) == 0) { if (d0 == 0) SN0 = __builtin_amdgcn_mfma_f32_32x32x16_bf16(kf[j & 3], qf[0], zero16, 0, 0, 0); else SN0 = __builtin_amdgcn_mfma_f32_32x32x16_bf16(kf[j & 3], qf[d0], SN0, 0, 0, 0); } \
            else { if (d0 == 0) SN1 = __builtin_amdgcn_mfma_f32_32x32x16_bf16(kf[j & 3], qf[0], zero16, 0, 0, 0); else SN1 = __builtin_amdgcn_mfma_f32_32x32x16_bf16(kf[j & 3], qf[d0], SN1, 0, 0, 0); } \
            if (j < 4) { const int j_ = j + 4; kf[j & 3] = *(LAS const bf16x8*)(lds + kn + kaddr + (j_ >> 1) * 32 + (j_ & 1) * 32 * KP); } \
            else { const int n_ = j - 4; vfr[2 * n_] = vtr(lds + vc_ + vaddr + n_ * 16 * VP); vfr[2 * n_ + 1] = vtr(lds + vc_ + vaddr + n_ * 16 * VP + 8 * VP); } \
            if (j == 0) { _Pragma("unroll") for (int e = 0; e < EPS; ++e) lsum += ATT_SV(SC0, SC1, (NSL - 1) * EPS + e); } \
            _Pragma("unroll") for (int w_ = 2 * j; w_ < 2 * j + 2; ++w_) { const int c = w_ >> 2, e = w_ & 3; \
                pp[c][e] = (c < 2) ? cvtpk(SC0[(8 * c + 2 * e) & 15], SC0[(8 * c + 2 * e + 1) & 15]) : cvtpk(SC1[(8 * (c - 2) + 2 * e) & 15], SC1[(8 * (c - 2) + 2 * e + 1) & 15]); } \
            __builtin_amdgcn_sched_barrier(0); } \
        *(LAS u32x4*)(lds + (kn ^ KBUF) + kl) = KST;              \
        _Pragma("unroll") for (int i = 0; i < NVC; ++i) *(LAS u32x4*)(lds + vn_ + vl + i * 32 * VP) = VST[i]; \
        __syncthreads(); \
        kn ^= KBUF; \
        { const int nx_ = ((T) == t0) ? 2 * VBUF : vp_; vp_ = vc_; vc_ = vn_; vn_ = nx_; } } while (0)
    for (int t = t0; t < t1; t += 2) {
        ATT_STEP(sc0, sc1, sd0, sd1, t, kreg, vreg, kreg2, vreg2);
        ATT_STEP(sd0, sd1, sc0, sc1, t + 1, kreg2, vreg2, kreg, vreg);
    }
#undef ATT_STEP
#pragma unroll
    for (int blk = 0; blk < DV / 32; ++blk)
#pragma unroll
        for (int c = 0; c < 4; ++c) {
            const s16x4 lo = vtr(lds + vp_ + vaddr + c * 16 * VP + blk * 64), hh = vtr(lds + vp_ + vaddr + c * 16 * VP + 8 * VP + blk * 64);
            const bf16x8 vf = (bf16x8){lo[0], lo[1], lo[2], lo[3], hh[0], hh[1], hh[2], hh[3]};
            o[blk] = __builtin_amdgcn_mfma_f32_32x32x16_bf16(vf, __builtin_bit_cast(bf16x8, pp[c]), o[blk], 0, 0, 0);
        }
    l_out = halfswap_add(lsum);
#undef ATT_QK
#undef ATT_MASK
#undef ATT_SV
#undef ATT_VF
}
__device__ __forceinline__ bool wg_any(LAS char* lds, bool bad) {
    LAS unsigned* flag = (LAS unsigned*)(lds + OFF_FLAG);
    __syncthreads();
    if (threadIdx.x == 0) *flag = 0u;
    __syncthreads();
    if (bad) *flag = 1u;
    __syncthreads();
    return *flag != 0u;
}
template <int NB> __device__ __forceinline__ bool pass_bad(const f32x16 (&o)[NB], float l) {
    float a = 0.f;
#pragma unroll
    for (int blk = 0; blk < NB; ++blk)
#pragma unroll
        for (int r = 0; r < 16; ++r) a += __builtin_fabsf(o[blk][r]);
    return !(l > 1e-30f && l < 1e30f && a < 1e30f);
}

__device__ __forceinline__ void diff_unit(LAS char* lds, int b, int h, int qb, const bf16_t* proj, bf16_t* aout, float* oscr, float lam_in, const float* subw) {
    const float lam = __builtin_bit_cast(float, __builtin_amdgcn_readfirstlane(__builtin_bit_cast(int, lam_in)));
    const size_t tok0 = (size_t)b * SEQ;
    f32x16 o[4]; float l;
#define DU_TID int tid_l = threadIdx.x; asm volatile("" : "+v"(tid_l)); const int tid = tid_l, lane = tid & 63, r32 = lane & 31, hi = lane >> 5, wid = __builtin_amdgcn_readfirstlane(tid >> 6); (void)hi; (void)r32; (void)wid;
#define DU_PTRS const int qrow = qb * 256 + wid * 32 + r32; const bf16_t* qp = proj + (tok0 + qrow) * NPROJ + 768 + h * 128; const bf16_t* kp = proj + tok0 * NPROJ + 1280 + h * 128; const bf16_t* vp = proj + tok0 * NPROJ + 1792 + h * 128;
    { DU_TID DU_PTRS
      flash_fast<128, false>(lds, qp, kp, vp, 0, SEQ / 64, 0, 0.f, o, l); }
    if (wg_any(lds, pass_bad<4>(o, l))) { DU_TID DU_PTRS flash_robust<128, false>(lds, qp, kp, vp, 0, SEQ / 64, 0, 0.f, 0.f, true, o, l); }
    {
        DU_TID
        f32x4* sc = (f32x4*)oscr + tid; asm volatile("" : "+v"(sc));
        const float inv = 1.0f / l;
#pragma unroll
        for (int blk = 0; blk < 4; ++blk)
#pragma unroll
            for (int g = 0; g < 4; ++g) sc[(blk * 4 + g) * 512] = (f32x4){o[blk][4 * g] * inv, o[blk][4 * g + 1] * inv, o[blk][4 * g + 2] * inv, o[blk][4 * g + 3] * inv};
    }
    { DU_TID DU_PTRS
      flash_fast<128, false>(lds, qp + 64, kp + 64, vp, 0, SEQ / 64, 0, 0.f, o, l); }
    if (wg_any(lds, pass_bad<4>(o, l))) { DU_TID DU_PTRS flash_robust<128, false>(lds, qp + 64, kp + 64, vp, 0, SEQ / 64, 0, 0.f, 0.f, true, o, l); }
    __syncthreads();
    DU_TID
    const float inv1 = lam / l;
    f32x4* sc = (f32x4*)oscr + tid; asm volatile("" : "+v"(sc));
    float ss = 0.f;
#pragma unroll
    for (int blk = 0; blk < 4; ++blk)
#pragma unroll
        for (int g = 0; g < 4; ++g) {
            const f32x4 a = sc[(blk * 4 + g) * 512];
#pragma unroll
            for (int j = 0; j < 4; ++j) { const float v = a[j] - o[blk][4 * g + j] * inv1; o[blk][4 * g + j] = v; ss += v * v; }
            if (g == 3) asm volatile("" : "+v"(ss) :: "memory");
        }
    ss += __shfl_xor(ss, 32);
    const float rs = __builtin_amdgcn_rsqf(ss * (1.0f / 128.0f) + 1e-5f) * 0.8f;
    LAS char* st = lds + OFF_ST + wid * ST_W;
#pragma unroll
    for (int blk = 0; blk < 4; ++blk)
#pragma unroll
        for (int g = 0; g < 4; ++g) {
            const int dv = 32 * blk + 8 * g + 4 * hi;
            const f32x4 w = *(const f32x4*)(subw + dv);
            u32x2 pw; pw.x = cvtpk(o[blk][4 * g] * rs * w[0], o[blk][4 * g + 1] * rs * w[1]); pw.y = cvtpk(o[blk][4 * g + 2] * rs * w[2], o[blk][4 * g + 3] * rs * w[3]);
            *(LAS u32x2*)(st + r32 * STP + dv * 2) = pw;
            if (g == 3) asm volatile("" ::: "memory");
        }
    bf16_t* ob = aout + (tok0 + qb * 256 + wid * 32) * DM + 512 + h * 128;
#pragma unroll
    for (int i = 0; i < 8; ++i) {
        const int idx = i * 64 + lane, row = idx >> 4, ch = idx & 15;
        const u32x4 v = *(LAS const u32x4*)(st + row * STP + ch * 16);
        *(u32x4*)(ob + (size_t)row * DM + ch * 8) = v;
    }
#undef DU_TID
#undef DU_PTRS
}

__device__ __forceinline__ void win_unit(LAS char* lds, int b, int kvh, int n, int hp, const bf16_t* proj, bf16_t* aout, const float* sink) {
    int tid_l = threadIdx.x; asm volatile("" : "+v"(tid_l)); const int tid = tid_l, lane = tid & 63, r32 = lane & 31, hi = lane >> 5, wid = __builtin_amdgcn_readfirstlane(tid >> 6);
    const size_t tok0 = (size_t)b * SEQ;
    const int a = kvh * 4 + 2 * hp + (wid >> 2);
    const int qrow = n * 128 + (wid & 3) * 32 + r32;
    const int t0 = (2 * n - 2 < 0) ? 0 : 2 * n - 2, t1 = (2 * n + 4 > SEQ / 64) ? SEQ / 64 : 2 * n + 4;
    f32x16 o[2]; float l;
    const float sink2 = sink[a] * LOG2E;
    flash_fast<64, true>(lds, proj + (tok0 + qrow) * NPROJ + a * 64, proj + tok0 * NPROJ + 512 + kvh * 64, proj + tok0 * NPROJ + 640 + kvh * 64,
                         t0, t1, qrow, __builtin_amdgcn_exp2f(sink2), o, l);
    if (wg_any(lds, pass_bad<2>(o, l)))
        flash_robust<64, true>(lds, proj + (tok0 + qrow) * NPROJ + a * 64, proj + tok0 * NPROJ + 512 + kvh * 64, proj + tok0 * NPROJ + 640 + kvh * 64,
                               t0, t1, qrow, sink2, 1.0f, false, o, l);
    __syncthreads();
    const float inv = 1.0f / l;
    LAS char* st = lds + OFF_ST + wid * ST_W;
#pragma unroll
    for (int blk = 0; blk < 2; ++blk)
#pragma unroll
        for (int g = 0; g < 4; ++g) {
            const int dv = 32 * blk + 8 * g + 4 * hi;
            u32x2 pw; pw.x = cvtpk(o[blk][4 * g] * inv, o[blk][4 * g + 1] * inv); pw.y = cvtpk(o[blk][4 * g + 2] * inv, o[blk][4 * g + 3] * inv);
            *(LAS u32x2*)(st + r32 * STP + dv * 2) = pw;
        }
    bf16_t* ob = aout + (tok0 + n * 128 + (wid & 3) * 32) * DM + a * 64;
#pragma unroll
    for (int i = 0; i < 4; ++i) {
        const int idx = i * 64 + lane, row = idx >> 3, ch = idx & 7;
        const u32x4 v = *(LAS const u32x4*)(st + row * STP + ch * 16);
        *(u32x4*)(ob + (size_t)row * DM + ch * 8) = v;
    }
}
constexpr int VPW = 192, VBW = 64 * VPW, RV = 6 * KBUF;
constexpr int RES_LDS = RV + 6 * VBW;
__device__ __forceinline__ void win_pass_fast(LAS char* lds, const bf16_t* Qrow, int nt, int t0, int qpos, float l_init, f32x16 (&o)[2], float& l_out) {
    int tid_l = threadIdx.x; asm volatile("" : "+v"(tid_l)); const int lane = tid_l & 63, r32 = lane & 31, hi = lane >> 5;
    bf16x8 qf[4];
#pragma unroll
    for (int d0 = 0; d0 < 4; ++d0) qf[d0] = *(const bf16x8*)(Qrow + d0 * 16 + hi * 8);
    const int kaddr = r32 * KP + hi * 16;
    const int vaddr = RV + (4 * hi + ((lane & 15) >> 2)) * VPW + (16 * ((lane >> 4) & 1) + 4 * (lane & 3)) * 2;
    const f32x16 zero16 = {0.f, 0.f, 0.f, 0.f, 0.f, 0.f, 0.f, 0.f, 0.f, 0.f, 0.f, 0.f, 0.f, 0.f, 0.f, 0.f};
    f32x16 sc0, sc1, sd0, sd1;
#pragma unroll
    for (int d0 = 0; d0 < 4; ++d0) {
        const bf16x8 k0_ = *(LAS const bf16x8*)(lds + kaddr + d0 * 32), k1_ = *(LAS const bf16x8*)(lds + kaddr + d0 * 32 + 32 * KP);
        if (d0 == 0) { sc0 = __builtin_amdgcn_mfma_f32_32x32x16_bf16(k0_, qf[0], zero16, 0, 0, 0); sc1 = __builtin_amdgcn_mfma_f32_32x32x16_bf16(k1_, qf[0], zero16, 0, 0, 0); }
        else { sc0 = __builtin_amdgcn_mfma_f32_32x32x16_bf16(k0_, qf[d0], sc0, 0, 0, 0); sc1 = __builtin_amdgcn_mfma_f32_32x32x16_bf16(k1_, qf[d0], sc1, 0, 0, 0); }
    }
    o[0] = zero16; o[1] = zero16;
    u32x4 pp[4] = {{0u, 0u, 0u, 0u}, {0u, 0u, 0u, 0u}, {0u, 0u, 0u, 0u}, {0u, 0u, 0u, 0u}};
    float lsum = (hi == 0) ? l_init : 0.f;
    int ks = KBUF, vp_ = 0, vc_ = 0;
    s16x4 vfr[8]; bf16x8 kf[4];
#pragma unroll
    for (int j = 0; j < 8; ++j) vfr[j] = vtr(lds + vaddr + (j >> 1) * 16 * VPW + (j & 1) * 8 * VPW);
#define WR_SV(S0, S1, i) ((i) < 16 ? S0[(i) & 15] : S1[(i) & 15])
#define WR_VF(s) ((bf16x8){vfr[(2 * (s)) & 7][0], vfr[(2 * (s)) & 7][1], vfr[(2 * (s)) & 7][2], vfr[(2 * (s)) & 7][3], vfr[(2 * (s) + 1) & 7][0], vfr[(2 * (s) + 1) & 7][1], vfr[(2 * (s) + 1) & 7][2], vfr[(2 * (s) + 1) & 7][3]})
#define WR_STEP(SC0, SC1, SN0, SN1, T) do { \
        { const int kb_ = 64 * (T) + 4 * hi - qpos + 128; \
          _Pragma("unroll") for (int r = 0; r < 16; ++r) { const int d_ = kb_ + (r & 3) + 8 * (r >> 2); \
              if ((unsigned)d_ > 256u) SC0[r] = -1e30f; if ((unsigned)(d_ + 32) > 256u) SC1[r] = -1e30f; } } \
        __builtin_amdgcn_sched_barrier(0); \
        _Pragma("unroll") for (int s_ = 0; s_ < 8; ++s_) { \
            const int blk = s_ >> 2, c = s_ & 3; \
            o[blk] = __builtin_amdgcn_mfma_f32_32x32x16_bf16(WR_VF(s_), __builtin_bit_cast(bf16x8, pp[c]), o[blk], 0, 0, 0); \
            if (s_ < 4) { vfr[(2 * s_) & 7] = vtr(lds + vp_ + vaddr + c * 16 * VPW + 64); vfr[(2 * s_ + 1) & 7] = vtr(lds + vp_ + vaddr + c * 16 * VPW + 8 * VPW + 64); } \
            else { const int j_ = s_ - 4; kf[j_] = *(LAS const bf16x8*)(lds + ks + kaddr + (j_ >> 1) * 32 + (j_ & 1) * 32 * KP); } \
            _Pragma("unroll") for (int e = 0; e < 4; ++e) { const int i_ = s_ * 4 + e; if (i_ < 16) SC0[i_ & 15] = __builtin_amdgcn_exp2f(SC0[i_ & 15]); else SC1[i_ & 15] = __builtin_amdgcn_exp2f(SC1[i_ & 15]); } \
            if (s_ > 0) { _Pragma("unroll") for (int e = 0; e < 4; ++e) lsum += WR_SV(SC0, SC1, (s_ - 1) * 4 + e); } \
            __builtin_amdgcn_sched_barrier(0); } \
        _Pragma("unroll") for (int j = 0; j < 8; ++j) { \
            const int d0 = j >> 1; \
            if ((j & 1) == 0) { if (d0 == 0) SN0 = __builtin_amdgcn_mfma_f32_32x32x16_bf16(kf[j & 3], qf[0], zero16, 0, 0, 0); else SN0 = __builtin_amdgcn_mfma_f32_32x32x16_bf16(kf[j & 3], qf[d0], SN0, 0, 0, 0); } \
            else { if (d0 == 0) SN1 = __builtin_amdgcn_mfma_f32_32x32x16_bf16(kf[j & 3], qf[0], zero16, 0, 0, 0); else SN1 = __builtin_amdgcn_mfma_f32_32x32x16_bf16(kf[j & 3], qf[d0], SN1, 0, 0, 0); } \
            if (j < 4) { const int j_ = j + 4; kf[j & 3] = *(LAS const bf16x8*)(lds + ks + kaddr + (j_ >> 1) * 32 + (j_ & 1) * 32 * KP); } \
            else { const int n_ = j - 4; vfr[2 * n_] = vtr(lds + vc_ + vaddr + n_ * 16 * VPW); vfr[2 * n_ + 1] = vtr(lds + vc_ + vaddr + n_ * 16 * VPW + 8 * VPW); } \
            if (j == 0) { _Pragma("unroll") for (int e = 0; e < 4; ++e) lsum += WR_SV(SC0, SC1, 28 + e); } \
            _Pragma("unroll") for (int w_ = 2 * j; w_ < 2 * j + 2; ++w_) { const int c = w_ >> 2, e = w_ & 3; \
                pp[c][e] = (c < 2) ? cvtpk(SC0[(8 * c + 2 * e) & 15], SC0[(8 * c + 2 * e + 1) & 15]) : cvtpk(SC1[(8 * (c - 2) + 2 * e) & 15], SC1[(8 * (c - 2) + 2 * e + 1) & 15]); } \
            __builtin_amdgcn_sched_barrier(0); } \
        ks += KBUF; vp_ = vc_; vc_ += VBW; } while (0)
    for (int i = 0; i < nt; i += 2) {
        WR_STEP(sc0, sc1, sd0, sd1, t0 + i);
        if (i == 0) vp_ = 0;
        WR_STEP(sd0, sd1, sc0, sc1, t0 + i + 1);
    }
#pragma unroll
    for (int blk = 0; blk < 2; ++blk)
#pragma unroll
        for (int c = 0; c < 4; ++c) {
            const s16x4 lo = vtr(lds + vp_ + vaddr + c * 16 * VPW + blk * 64), hh = vtr(lds + vp_ + vaddr + c * 16 * VPW + 8 * VPW + blk * 64);
            const bf16x8 vf = (bf16x8){lo[0], lo[1], lo[2], lo[3], hh[0], hh[1], hh[2], hh[3]};
            o[blk] = __builtin_amdgcn_mfma_f32_32x32x16_bf16(vf, __builtin_bit_cast(bf16x8, pp[c]), o[blk], 0, 0, 0);
        }
    l_out = halfswap_add(lsum);
#undef WR_SV
#undef WR_VF
#undef WR_STEP
}
__device__ __forceinline__ void win_pass_robust(LAS char* lds, const bf16_t* Qrow, int nt, int t0, int qpos, float sink2, f32x16 (&o)[2], float& l_out) {
    int tid_l = threadIdx.x; asm volatile("" : "+v"(tid_l)); const int lane = tid_l & 63, r32 = lane & 31, hi = lane >> 5;
    bf16x8 qf[4];
#pragma unroll
    for (int d0 = 0; d0 < 4; ++d0) qf[d0] = *(const bf16x8*)(Qrow + d0 * 16 + hi * 8);
    const int kaddr = r32 * KP + hi * 16;
    const int vaddr = RV + (4 * hi + ((lane & 15) >> 2)) * VPW + (16 * ((lane >> 4) & 1) + 4 * (lane & 3)) * 2;
    float mref = sink2, lsum = (hi == 0) ? 1.0f : 0.f;
#pragma unroll
    for (int blk = 0; blk < 2; ++blk)
#pragma unroll
        for (int r = 0; r < 16; ++r) o[blk][r] = 0.f;
    for (int i = 0; i < nt; ++i) {
        LAS const char* Kc = lds + i * KBUF + kaddr;
        LAS const char* Vc = lds + i * VBW + vaddr;
        f32x16 p0, p1;
#pragma unroll
        for (int r = 0; r < 16; ++r) { p0[r] = -mref; p1[r] = -mref; }
#pragma unroll
        for (int d0 = 0; d0 < 4; ++d0) {
            const bf16x8 k0 = *(LAS const bf16x8*)(Kc + d0 * 32), k1 = *(LAS const bf16x8*)(Kc + d0 * 32 + 32 * KP);
            p0 = __builtin_amdgcn_mfma_f32_32x32x16_bf16(k0, qf[d0], p0, 0, 0, 0);
            p1 = __builtin_amdgcn_mfma_f32_32x32x16_bf16(k1, qf[d0], p1, 0, 0, 0);
        }
        { const int kb = 64 * (t0 + i) + 4 * hi - qpos + 128;
#pragma unroll
          for (int r = 0; r < 16; ++r) { const int d = kb + (r & 3) + 8 * (r >> 2); if ((unsigned)d > 256u) p0[r] = -1e30f; if ((unsigned)(d + 32) > 256u) p1[r] = -1e30f; } }
        float rm = fmaxf(p0[0], p1[0]);
#pragma unroll
        for (int r = 1; r < 16; ++r) rm = fmaxf(rm, fmaxf(p0[r], p1[r]));
        rm = fmaxf(rm, __shfl_xor(rm, 32));
        if (__any(rm > 8.0f)) {
            const float dl = fmaxf(rm, 0.f), al = __builtin_amdgcn_exp2f(-dl);
            mref += dl; lsum *= al;
#pragma unroll
            for (int r = 0; r < 16; ++r) { p0[r] -= dl; p1[r] -= dl; o[0][r] *= al; o[1][r] *= al; }
        }
        float s0 = 0.f;
#pragma unroll
        for (int r = 0; r < 16; ++r) { p0[r] = __builtin_amdgcn_exp2f(p0[r]); p1[r] = __builtin_amdgcn_exp2f(p1[r]); s0 += p0[r] + p1[r]; }
        lsum += s0;
        u32x4 pk[4];
#pragma unroll
        for (int c = 0; c < 2; ++c) {
            pk[c].x = cvtpk(p0[8 * c + 0], p0[8 * c + 1]); pk[c].y = cvtpk(p0[8 * c + 2], p0[8 * c + 3]); pk[c].z = cvtpk(p0[8 * c + 4], p0[8 * c + 5]); pk[c].w = cvtpk(p0[8 * c + 6], p0[8 * c + 7]);
            pk[2 + c].x = cvtpk(p1[8 * c + 0], p1[8 * c + 1]); pk[2 + c].y = cvtpk(p1[8 * c + 2], p1[8 * c + 3]); pk[2 + c].z = cvtpk(p1[8 * c + 4], p1[8 * c + 5]); pk[2 + c].w = cvtpk(p1[8 * c + 6], p1[8 * c + 7]);
        }
#pragma unroll
        for (int blk = 0; blk < 2; ++blk)
#pragma unroll
            for (int c = 0; c < 4; ++c) {
                const s16x4 lo = vtr(Vc + c * 16 * VPW + blk * 64), hh = vtr(Vc + c * 16 * VPW + 8 * VPW + blk * 64);
                const bf16x8 vf = (bf16x8){lo[0], lo[1], lo[2], lo[3], hh[0], hh[1], hh[2], hh[3]};
                o[blk] = __builtin_amdgcn_mfma_f32_32x32x16_bf16(vf, __builtin_bit_cast(bf16x8, pk[c]), o[blk], 0, 0, 0);
            }
    }
    l_out = lsum + __shfl_xor(lsum, 32);
}
__device__ __forceinline__ void win_unit4(LAS char* lds, int b, int kvh, int n, const bf16_t* proj, bf16_t* aout, const float* sink) {
    const size_t tok0 = (size_t)b * SEQ;
    const int t0 = (2 * n - 2 < 0) ? 0 : 2 * n - 2, t1 = (2 * n + 4 > SEQ / 64) ? SEQ / 64 : 2 * n + 4, nt = t1 - t0;
    {
        int tid_l = threadIdx.x; asm volatile("" : "+v"(tid_l)); const int tid = tid_l, krow = tid >> 3, kch = tid & 7;
        const bf16_t* kg = proj + (tok0 + (size_t)t0 * 64 + krow) * NPROJ + 512 + kvh * 64 + kch * 8;
        u32x4 kr[6], vr[6];
#pragma unroll
        for (int i = 0; i < 6; ++i) if (i < nt) { kr[i] = *(const u32x4*)(kg + (size_t)i * 64 * NPROJ); vr[i] = *(const u32x4*)(kg + (size_t)i * 64 * NPROJ + 128); }
        __syncthreads();
#pragma unroll
        for (int i = 0; i < 6; ++i) if (i < nt) { *(LAS u32x4*)(lds + i * KBUF + krow * KP + kch * 16) = kr[i]; *(LAS u32x4*)(lds + RV + i * VBW + krow * VPW + kch * 16) = vr[i]; }
        __syncthreads();
    }
#pragma unroll 1
    for (int hp = 0; hp < 2; ++hp) {
        int tid_l = threadIdx.x; asm volatile("" : "+v"(tid_l)); const int tid = tid_l, lane = tid & 63, r32 = lane & 31, hi = lane >> 5, wid = __builtin_amdgcn_readfirstlane(tid >> 6);
        const int a = kvh * 4 + 2 * hp + (wid >> 2);
        const int qrow = n * 128 + (wid & 3) * 32 + r32;
        const float sink2 = sink[a] * LOG2E;
        const bf16_t* qp = proj + (tok0 + qrow) * NPROJ + a * 64;
        f32x16 o[2]; float l;
        win_pass_fast(lds, qp, nt, t0, qrow, __builtin_amdgcn_exp2f(sink2), o, l);
        if (__any(pass_bad<2>(o, l))) win_pass_robust(lds, qp, nt, t0, qrow, sink2, o, l);
        const float inv = 1.0f / l;
        bf16_t* ob = aout + (tok0 + qrow) * DM + a * 64 + 4 * hi;
#pragma unroll
        for (int blk = 0; blk < 2; ++blk)
#pragma unroll
            for (int g = 0; g < 4; ++g) {
                u32x2 pw; pw.x = cvtpk(o[blk][4 * g] * inv, o[blk][4 * g + 1] * inv); pw.y = cvtpk(o[blk][4 * g + 2] * inv, o[blk][4 * g + 3] * inv);
                *(u32x2*)(ob + 32 * blk + 8 * g) = pw;
            }
    }
}
}

constexpr size_t MiB = 1u << 20;
constexpr size_t WS_MOD = 0;
constexpr size_t WS_COS = 1 * MiB, WS_SIN = 1 * MiB + 512 * 1024;
constexpr size_t WS_ST1 = 3 * MiB;
constexpr size_t WS_WIN = 4 * MiB, WS_WAB = 13 * MiB, WS_WO = 15 * MiB, WS_WGU = 17 * MiB, WS_WDN = 28 * MiB;
constexpr size_t WS_OSCR = 34 * MiB;
constexpr size_t WS_MRG = 66 * MiB;
constexpr size_t WS_PROJ = 226 * MiB;
constexpr size_t WS_END = 906 * MiB;
constexpr int LDS_BYTES = 147456;
constexpr int NWAVES = 8;
typedef float f32x4 __attribute__((ext_vector_type(4)));
typedef float f32x2g __attribute__((ext_vector_type(2)));
typedef unsigned u32x4g __attribute__((ext_vector_type(4)));
typedef unsigned short bf16;

#ifndef REPEAT_MASK
#define REPEAT_MASK 0
#endif
#ifndef PHASE_MASK
#define PHASE_MASK 0x3ff
#endif
struct Params { const float* in[22]; float* out; unsigned char* ws; };
enum { I_XP = 0, I_XS, I_CP, I_CS, I_WADA, I_BADA, I_WIN, I_SINK, I_LQ1, I_LK1, I_LQ2, I_LK2, I_SUBW, I_WA, I_WB, I_WO, I_LN1G, I_LN1B, I_WGU, I_WDN, I_LN2G, I_LN2B };

__device__ const float ROPE_INV[32] = {1.000000000e+00f, 7.498942018e-01f, 5.623413324e-01f, 4.216965139e-01f, 3.162277639e-01f, 2.371373922e-01f, 1.778279394e-01f, 1.333521456e-01f,
    1.000000015e-01f, 7.498941571e-02f, 5.623412877e-02f, 4.216964915e-02f, 3.162277862e-02f, 2.371373586e-02f, 1.778279431e-02f, 1.333521493e-02f,
    9.999999776e-03f, 7.498942316e-03f, 5.623413250e-03f, 4.216964822e-03f, 3.162277862e-03f, 2.371373819e-03f, 1.778279431e-03f, 1.333521446e-03f,
    1.000000047e-03f, 7.498941850e-04f, 5.623413017e-04f, 4.216965463e-04f, 3.162277862e-04f, 2.371373848e-04f, 1.778279402e-04f, 1.333521504e-04f};

__device__ __forceinline__ unsigned f2bf(float f) { unsigned u = __builtin_bit_cast(unsigned, f); return (u + 0x7fffu + ((u >> 16) & 1u)) >> 16; }
__device__ __forceinline__ unsigned pk2(float lo, float hi) { return f2bf(lo) | (f2bf(hi) << 16); }
__device__ __forceinline__ float wave_sum(float v) {
#pragma unroll
    for (int o = 1; o < 64; o <<= 1) v += __shfl_xor(v, o);
    return v;
}
__device__ __forceinline__ int colmap(int mode, int L) {
    if (mode == 1) {
        if (L < 640 || (L >= 768 && L < 1792)) { const int j = L & 63, base = L - j; return base + (j < 32 ? 2 * j : 2 * (j - 32) + 1); }
        return L;
    }
    if (mode == 2) {
        if (L < DFF) return (L >> 7) * 256 + (L & 127);
        const int i = L - DFF; return (i >> 7) * 256 + 128 + (i & 127);
    }
    return L;
}
__device__ __forceinline__ void tr_item(const float* W, int N, bf16* WT, int ldt, int koff, int item, int mode, LAS float* scr, int lane) {
    const int nblk = N / 32, kb = item / nblk, nb = item % nblk, k0 = 64 * kb, n0 = 32 * nb;
#pragma unroll 8
    for (int i = 0; i < 32; ++i) { const int kk = 2 * i + (lane >> 5); scr[kk * 33 + (lane & 31)] = W[(size_t)(k0 + kk) * N + n0 + (lane & 31)]; }
    asm volatile("s_waitcnt lgkmcnt(0)" ::: "memory");
    const int c = lane & 7;
#pragma unroll
    for (int j = 0; j < 4; ++j) {
        const int n = (lane >> 3) + 8 * j; const LAS float* s = scr + (8 * c) * 33 + n;
        u32x4g o; o.x = pk2(s[0 * 33], s[1 * 33]); o.y = pk2(s[2 * 33], s[3 * 33]); o.z = pk2(s[4 * 33], s[5 * 33]); o.w = pk2(s[6 * 33], s[7 * 33]);
        *(u32x4g*)(WT + (size_t)colmap(mode, n0 + n) * ldt + koff + k0 + 8 * c) = o;
    }
    asm volatile("s_waitcnt lgkmcnt(0)" ::: "memory");
}

__device__ __forceinline__ void sincos_d(double a, float& sn, float& cs) {
    const double n = __builtin_rint(a * 0.63661977236758134308);
    double r = __builtin_fma(-n, 1.57079632679489655800, a);
    r = __builtin_fma(-n, 6.12323399573676603587e-17, r);
    const double r2 = r * r;
    double s = 1.0 / 6227020800.0;
    s = s * r2 - 1.0 / 39916800.0; s = s * r2 + 1.0 / 362880.0; s = s * r2 - 1.0 / 5040.0; s = s * r2 + 1.0 / 120.0; s = s * r2 - 1.0 / 6.0;
    s = r + r * r2 * s;
    double c = -1.0 / 87178291200.0;
    c = c * r2 + 1.0 / 479001600.0; c = c * r2 - 1.0 / 3628800.0; c = c * r2 + 1.0 / 40320.0; c = c * r2 - 1.0 / 720.0; c = c * r2 + 1.0 / 24.0; c = c * r2 - 0.5;
    c = 1.0 + r2 * c;
    const int q = ((int)n) & 3;
    const double ss = (q == 0) ? s : (q == 1) ? c : (q == 2) ? -s : -c;
    const double cc = (q == 0) ? c : (q == 1) ? -s : (q == 2) ? -c : s;
    sn = (float)ss; cs = (float)cc;
}

#define XB_TMO      128
#define XB_XCNT(j)  (256  + 64 * (j))
#define XB_XSUB(j)  (1280 + 64 * (j))
#define XB_XGEN(j)  (2304 + 64 * (j))
#define XB_TOP      3328
#define XB_TOPGEN   3392
#define XCD_BAR_WORDS 3456
#define XB_SPIN_CAP (1u << 18)

__device__ __forceinline__ unsigned xb_ld(unsigned* p)              { return __hip_atomic_load(p, __ATOMIC_RELAXED, __HIP_MEMORY_SCOPE_AGENT); }
__device__ __forceinline__ unsigned xb_add(unsigned* p, unsigned v) { return __hip_atomic_fetch_add(p, v, __ATOMIC_RELAXED, __HIP_MEMORY_SCOPE_AGENT); }
__device__ __forceinline__ unsigned xb_xcc_id() { return (unsigned)__builtin_amdgcn_s_getreg((3 << 11) | 20) & 0xFu; }
#define XB_SPIN(cond, bar) do { unsigned _sp = 0; while (cond) { __builtin_amdgcn_s_sleep(1); \
    if ((++_sp & 255u) == 0u) { if (xb_ld(&(bar)[XB_TMO])) break; if (_sp > XB_SPIN_CAP) { atomicAdd(&(bar)[XB_TMO], 1u); break; } } } } while (0)

struct XcdBarrier {
    unsigned* bar; unsigned x;
    volatile LAS unsigned* st;
};

__device__ __forceinline__ XcdBarrier xcd_barrier_post(unsigned* bar, volatile LAS unsigned* st) {
    XcdBarrier b; b.bar = bar; b.x = xb_xcc_id(); b.st = st;
    if (threadIdx.x == 0) (void)xb_add(&bar[XB_XCNT(b.x)], 1u);
    return b;
}
__device__ __forceinline__ void xcd_barrier_complete(unsigned* bar, unsigned x, unsigned& nloc, unsigned& nx) {
    const unsigned G = gridDim.x * gridDim.y * gridDim.z;
    unsigned sum, cnt, mine, sp = 0u;
    for (;;) {
        sum = 0u; cnt = 0u; mine = 0u;
#pragma unroll
        for (unsigned j = 0; j < 16; ++j) { const unsigned c = xb_ld(&bar[XB_XCNT(j)]); sum += c; cnt += (c > 0u) ? 1u : 0u; mine = (j == x) ? c : mine; }
        if (sum == G) break;
        __builtin_amdgcn_s_sleep(1);
        if ((++sp & 255u) == 0u) { if (xb_ld(&bar[XB_TMO])) break; if (sp > XB_SPIN_CAP) { atomicAdd(&bar[XB_TMO], 1u); break; } }
    }
    nloc = mine > 0u ? mine : 1u; nx = cnt > 0u ? cnt : 1u;
}

__device__ __forceinline__ void xcd_barrier(const XcdBarrier& b) {
    asm volatile("s_waitcnt vmcnt(0)" ::: "memory");
    __syncthreads();
    if (threadIdx.x == 0) {
        unsigned* bar = b.bar;
        __builtin_amdgcn_s_waitcnt(0);
        unsigned nloc = b.st[0], nx = b.st[1];
        if (nloc == 0u) { xcd_barrier_complete(bar, b.x, nloc, nx); b.st[0] = nloc; b.st[1] = nx; }
        const unsigned old = xb_add(&bar[XB_XSUB(b.x)], 1u);
        const unsigned gen = old / nloc;
        if (old + 1u == (gen + 1u) * nloc) {
            __builtin_amdgcn_fence(__ATOMIC_RELEASE, "agent");
            asm volatile("s_waitcnt vmcnt(0)" ::: "memory");
            const unsigned og = xb_add(&bar[XB_TOP], 1u);
            const unsigned tg = og / nx;
            if (og + 1u == (tg + 1u) * nx) xb_add(&bar[XB_TOPGEN], 1u);
            else XB_SPIN(xb_ld(&bar[XB_TOPGEN]) == tg, bar);
            __builtin_amdgcn_fence(__ATOMIC_ACQUIRE, "agent");
            xb_add(&bar[XB_XGEN(b.x)], 1u);
            asm volatile("s_waitcnt vmcnt(0)" ::: "memory");
        } else {
            XB_SPIN(xb_ld(&bar[XB_XGEN(b.x)]) == gen, bar);
            __builtin_amdgcn_fence(__ATOMIC_ACQUIRE, "agent");
            asm volatile("s_waitcnt vmcnt(0)" ::: "memory");
        }
    }
    __syncthreads();
}

constexpr size_t WS_BAR = 491520;
constexpr size_t WS_ZERO_BYTES = WS_BAR + 16384;
static_assert(XCD_BAR_WORDS * 4 <= 16384 && WS_ZERO_BYTES <= WS_COS && (size_t)NBATCH * MODN * 4 <= WS_BAR, "control words");
constexpr int XB_LDS_OFF = LDS_BYTES - 64;
__device__ __forceinline__ void ada_item(const float* cp, const float* cs, const float* wada, float* modb, int cb, int k0, int nk, int lane) {
    const int n = cb * 64 + lane;
    float sv[NBATCH], acc[NBATCH];
#pragma unroll
    for (int b = 0; b < NBATCH; ++b) {
        const float c = (lane < nk) ? ((b < 16) ? cp[b * DM + k0 + lane] : cs[(b - 16) * DM + k0 + lane]) : 0.f;
        sv[b] = c * sigmoidf_fast(c); acc[b] = 0.f;
    }
    const float* wp = wada + (size_t)k0 * MODN + n;
#pragma unroll 16
    for (int kk = 0; kk < nk; ++kk) {
        const float w = wp[(size_t)kk * MODN];
#pragma unroll
        for (int b = 0; b < NBATCH; ++b) acc[b] += __builtin_bit_cast(float, __builtin_amdgcn_readlane(__builtin_bit_cast(int, sv[b]), kk)) * w;
    }
#pragma unroll
    for (int b = 0; b < NBATCH; ++b) atomicAdd(modb + b * MODN + n, acc[b]);
}
__global__ void __launch_bounds__(NWAVES * 64, 2) mega_fwd(Params P) {
    extern __shared__ __attribute__((aligned(16))) unsigned char lds_raw[];
    cg::grid_group grid = cg::this_grid();
    LAS unsigned char* lds = (LAS unsigned char*)lds_raw;
    volatile LAS unsigned* xst = (volatile LAS unsigned*)(lds + XB_LDS_OFF);
    if (threadIdx.x < 2) xst[threadIdx.x] = 0u;
    __syncthreads();
    const XcdBarrier xbar = xcd_barrier_post((unsigned*)(P.ws + WS_BAR), xst);
#define PHASE_VARS \
    int tid = threadIdx.x; asm volatile("" : "+v"(tid)); \
    const int lane = tid & 63, wid = __builtin_amdgcn_readfirstlane(tid >> 6); \
    const int G = gridDim.x, bid = blockIdx.x; \
    const int vcu = (G % 8 == 0) ? (bid % 8) * (G / 8) + bid / 8 : bid; \
    unsigned char* ws = P.ws; \
    float* modb = (float*)(ws + WS_MOD); float* cosT = (float*)(ws + WS_COS); float* sinT = (float*)(ws + WS_SIN); \
    f32x2g* st1 = (f32x2g*)(ws + WS_ST1); \
    bf16* Win_t = (bf16*)(ws + WS_WIN); bf16* Wab_t = (bf16*)(ws + WS_WAB); bf16* Wo_t = (bf16*)(ws + WS_WO); bf16* Wgu_t = (bf16*)(ws + WS_WGU); bf16* Wdn_t = (bf16*)(ws + WS_WDN); \
    bf16* mrg = (bf16*)(ws + WS_MRG); bf16* proj = (bf16*)(ws + WS_PROJ); bf16* hid = (bf16*)(ws + WS_PROJ); \
    bf16* hbuf = (bf16*)P.out; bf16* aout = (bf16*)((unsigned char*)P.out + 160 * MiB); float* Y = P.out; \
    h16_t* Y16 = (h16_t*)P.out; h16_t* Z16 = (h16_t*)(ws + WS_MRG); (void)Y16; (void)Z16;     \
    const float* bada = P.in[I_BADA]; \
    const int gw = bid * NWAVES + wid, NGW = G * NWAVES; \
    (void)lane; (void)vcu; (void)modb; (void)cosT; (void)sinT; (void)st1; (void)Win_t; (void)Wab_t; (void)Wo_t; (void)Wgu_t; (void)Wdn_t; (void)mrg; (void)proj; (void)hid; (void)hbuf; (void)aout; (void)Y; (void)bada; (void)gw; (void)NGW;

    if constexpr ((PHASE_MASK >> 0) & 1) {
        PHASE_VARS
        for (int it = gw; it < 32 * 64; it += NGW) ada_item(P.in[I_CP], P.in[I_CS], P.in[I_WADA], modb, it % 32, (it / 32) * 16, 16, lane);
    }
    if (P.ws == nullptr) grid.sync();
    xcd_barrier(xbar);
    if constexpr ((PHASE_MASK >> 0) & 1) {
        PHASE_VARS
        for (int e = bid * (NWAVES * 64) + tid; e < SEQ * 32; e += G * NWAVES * 64) {
            const int pos = e >> 5, i = e & 31;
            const float ang = (float)pos * ROPE_INV[i];
            float sn, cs; sincos_d((double)ang, sn, cs);
            cosT[e] = cs; sinT[e] = sn;
        }
        LAS float* scr = (LAS float*)(lds + wid * 8704);
        constexpr int I_IN = 16 * (NPROJ / 32), I_A = 8 * 32, I_O = 16 * 32, I_GU = 16 * (2 * DFF / 32), I_DN = (DFF / 64) * 32;
        constexpr int NITEMS = I_IN + 2 * I_A + I_O + I_GU + I_DN;
        (void)NITEMS;
        for (int it = gw; it < I_IN; it += NGW) tr_item(P.in[I_WIN], NPROJ, Win_t, DM, 0, it, 1, scr, lane);
    }

    for (int rep_ = 0; rep_ < (int)((REPEAT_MASK >> 1) & 1) + 1; ++rep_) {
        if (rep_) grid.sync();
        PHASE_VARS
        constexpr int RPW = 40;
        for (int ch = gw; ch < T_TOK / RPW; ch += NGW) {
            int curb = -1; f32x4 A[4], B[4];
            f32x4 xv[4], xn[4], xm[4];
#define P1_XROW(r_) (((r_) < 65536) ? P.in[I_XP] + (size_t)(r_) * DM : P.in[I_XS] + (size_t)((r_) - 65536) * DM)
            { const float* xr = P1_XROW(ch * RPW);
#pragma unroll
              for (int j = 0; j < 4; ++j) xv[j] = __builtin_nontemporal_load((const f32x4*)(xr + 4 * lane + 256 * j));
              const float* xr1 = P1_XROW(ch * RPW + 1);
#pragma unroll
              for (int j = 0; j < 4; ++j) xn[j] = __builtin_nontemporal_load((const f32x4*)(xr1 + 4 * lane + 256 * j)); }
            for (int r = ch * RPW; r < ch * RPW + RPW; ++r) {
                if (r + 2 < ch * RPW + RPW) { const float* xr = P1_XROW(r + 2);
#pragma unroll
                    for (int j = 0; j < 4; ++j) xm[j] = __builtin_nontemporal_load((const f32x4*)(xr + 4 * lane + 256 * j)); }
                const int b = r >> 12;
                if (b != curb) { curb = b;
#pragma unroll
                    for (int j = 0; j < 4; ++j) { const int c = 4 * lane + 256 * j;
                        A[j] = *(const f32x4*)(modb + b * MODN + DM + c) + *(const f32x4*)(bada + DM + c) + 1.0f;
                        B[j] = *(const f32x4*)(modb + b * MODN + c) + *(const f32x4*)(bada + c); } }
#pragma unroll
                for (int j = 0; j < 4; ++j) { const int c = 4 * lane + 256 * j;
                    const f32x4 v = xv[j] * A[j] + B[j];
                    u32x2 w; w.x = pk2(v[0], v[1]); w.y = pk2(v[2], v[3]);
                    *(u32x2*)(hbuf + (size_t)r * DM + c) = w; }
#pragma unroll
                for (int j = 0; j < 4; ++j) { xv[j] = xn[j]; xn[j] = xm[j]; }
            }
#undef P1_XROW
        }
    }
    xcd_barrier(xbar);

    for (int rep_ = 0; rep_ < (int)((REPEAT_MASK >> 2) & 1) + 1; ++rep_) {
        if (rep_) grid.sync();
        PHASE_VARS
        pg8::Gemm g{hbuf, Win_t, T_TOK, NPROJ, DM}; pg8::StaticOrder S; S.init(T_TOK, NPROJ, G, bid);
        pg8::EpiProj E{proj, cosT, sinT};
        pg8::gemm_phase<pg8::EpiProj, pg8::StaticOrder, true, true>(lds, g, S, E);
        if (rep_ == 0) {
            constexpr int I_A = 8 * 32, I_O = 16 * 32, I_GU = 16 * (2 * DFF / 32), I_DN = (DFF / 64) * 32, NREST = 2 * I_A + I_O + I_GU + I_DN;
            const int rem = ((T_TOK / 256) * (NPROJ / 256)) % G;
            const int nh = (rem == 0) ? G : G - rem, hb = (rem == 0) ? bid : bid - rem;
            if (hb >= 0) {
                for (int it = hb * NWAVES + wid; it < 64 * 16; it += nh * NWAVES) ada_item(P.in[I_CP], P.in[I_CS], P.in[I_WADA], modb, 32 + it % 64, (it / 64) * 64, 64, lane);
                LAS float* scr = (LAS float*)(lds + wid * 8704);
                for (int it = hb * NWAVES + wid; it < NREST; it += nh * NWAVES) {
                    int r = it;
                    if (r < I_A) { tr_item(P.in[I_WA], DM, Wab_t, DM, 0, r, 0, scr, lane); continue; } r -= I_A;
                    if (r < I_A) { tr_item(P.in[I_WB], DM, Wab_t, DM, 512, r, 0, scr, lane); continue; } r -= I_A;
                    if (r < I_O) { tr_item(P.in[I_WO], DM, Wo_t, DM, 0, r, 0, scr, lane); continue; } r -= I_O;
                    if (r < I_GU) { tr_item(P.in[I_WGU], 2 * DFF, Wgu_t, DM, 0, r, 2, scr, lane); continue; } r -= I_GU;
                    tr_item(P.in[I_WDN], DM, Wdn_t, DFF, 0, r, 0, scr, lane);
                }
            }
        }
    }
    xcd_barrier(xbar);

    for (int rep_ = 0; rep_ < (int)((REPEAT_MASK >> 3) & 1) + 1; ++rep_) {
        if (rep_) grid.sync();
        PHASE_VARS
        float lam;
        {
            const float a = P.in[I_LQ1][lane] * P.in[I_LK1][lane], b2 = P.in[I_LQ2][lane] * P.in[I_LK2][lane];
            lam = __expf(wave_sum(a)) - __expf(wave_sum(b2)) + 0.2f;
        }
        float* oscr = (float*)(ws + WS_OSCR) + (size_t)bid * 32768;
        for (int u = vcu; u < NBATCH * 4 * 16; u += G) {
            const int qb = u & 15, bh = u >> 4;
            att::diff_unit((LAS char*)lds, bh >> 2, bh & 3, qb, proj, aout, oscr, lam, P.in[I_SUBW]);
        }
        static_assert(att::RES_LDS <= XB_LDS_OFF, "resident window tiles fit under the barrier words");
        for (int u = vcu; u < NBATCH * 2 * 32; u += G) {
            const int n = u & 31, bk = u >> 5;
            att::win_unit4((LAS char*)lds, bk >> 1, bk & 1, n, proj, aout, P.in[I_SINK]);
        }
    }
    xcd_barrier(xbar);

    for (int rep_ = 0; rep_ < (int)((REPEAT_MASK >> 4) & 1) + 1; ++rep_) {
        if (rep_) grid.sync();
        PHASE_VARS
        pg8::Gemm g{aout, Wab_t, T_TOK, DM, DM}; pg8::StaticOrder S; S.init(T_TOK, DM, G, bid);
        pg8::EpiMerge E{proj, mrg};
        pg8::gemm_phase<pg8::EpiMerge, pg8::StaticOrder, true, true>(lds, g, S, E);
    }
    xcd_barrier(xbar);

    for (int rep_ = 0; rep_ < (int)((REPEAT_MASK >> 5) & 1) + 1; ++rep_) {
        if (rep_) grid.sync();
        PHASE_VARS
        pg8::Gemm g{mrg, Wo_t, T_TOK, DM, DM}; pg8::StaticOrder S; S.init(T_TOK, DM, G, bid);
        pg8::EpiWo E{P.in[I_XP], P.in[I_XS], modb, bada, Y16};
        pg8::gemm_phase<pg8::EpiWo, pg8::StaticOrder, true, true>(lds, g, S, E);
    }
    xcd_barrier(xbar);

    for (int rep_ = 0; rep_ < (int)((REPEAT_MASK >> 6) & 1) + 1; ++rep_) {
        if (rep_) grid.sync();
        PHASE_VARS
        constexpr int RPW = 40;
        f32x4 G1[4], B1[4];
#pragma unroll
        for (int j = 0; j < 4; ++j) { const int c = 4 * lane + 256 * j; G1[j] = *(const f32x4*)(P.in[I_LN1G] + c); B1[j] = *(const f32x4*)(P.in[I_LN1B] + c); }
        for (int ch = gw; ch < T_TOK / RPW; ch += NGW) {
            int curb = -1; f32x4 A[4], B[4]; h16x4 pa[4], pb[4];
            for (int r = ch * RPW; r < ch * RPW + RPW; ++r) {
                const int b = r >> 12;
                if (b != curb) { curb = b;
#pragma unroll
                    for (int j = 0; j < 4; ++j) { const int c = 4 * lane + 256 * j;
                        A[j] = *(const f32x4*)(modb + b * MODN + 4 * DM + c) + *(const f32x4*)(bada + 4 * DM + c) + 1.0f;
                        B[j] = *(const f32x4*)(modb + b * MODN + 3 * DM + c) + *(const f32x4*)(bada + 3 * DM + c); } }
#define P6_LD(dst, r_) do { _Pragma("unroll") for (int j = 0; j < 4; ++j) dst[j] = *(const h16x4*)(Y16 + (size_t)(r_) * DM + 4 * lane + 256 * j); } while (0)
                if (r == ch * RPW) { P6_LD(pa, r); P6_LD(pb, r + 1); }
                f32x4 v[4]; float s = 0.f;
#pragma unroll
                for (int j = 0; j < 4; ++j) { v[j] = __builtin_convertvector(pa[j], f32x4); pa[j] = pb[j]; s += (v[j][0] + v[j][1]) + (v[j][2] + v[j][3]); }
                if (r + 2 < ch * RPW + RPW) P6_LD(pb, r + 2);
#undef P6_LD
                const float mean = wave_sum(s) * (1.0f / DM); float q = 0.f;
#pragma unroll
                for (int j = 0; j < 4; ++j) { const f32x4 d = v[j] - mean; q += (d[0] * d[0] + d[1] * d[1]) + (d[2] * d[2] + d[3] * d[3]); }
                const float rstd = 1.0f / sqrtf(wave_sum(q) * (1.0f / DM) + LN_EPS);
                if (lane == 0) st1[r] = (f32x2g){mean, rstd};
#pragma unroll
                for (int j = 0; j < 4; ++j) { const int c = 4 * lane + 256 * j;
                    const f32x4 x1 = (v[j] - mean) * rstd * G1[j] + B1[j];
                    const f32x4 hv = x1 * A[j] + B[j];
                    u32x2 w; w.x = pk2(hv[0], hv[1]); w.y = pk2(hv[2], hv[3]);
                    *(u32x2*)(mrg + (size_t)r * DM + c) = w; }
            }
        }
    }
    xcd_barrier(xbar);

    for (int rep_ = 0; rep_ < (int)((REPEAT_MASK >> 7) & 1) + 1; ++rep_) {
        if (rep_) grid.sync();
        PHASE_VARS
        pg8::Gemm g{mrg, Wgu_t, T_TOK, 2 * DFF, DM}; pg8::StaticOrder S; S.init(T_TOK, 2 * DFF, G, bid);
        pg8::EpiGU E{hid};
        pg8::gemm_phase<pg8::EpiGU, pg8::StaticOrder, true, true>(lds, g, S, E);
    }
    xcd_barrier(xbar);

    if constexpr ((PHASE_MASK >> 8) & 1) {
        PHASE_VARS
        pg8::Gemm g{hid, Wdn_t, T_TOK, DM, DFF}; pg8::StaticOrder S; S.init(T_TOK, DM, G, bid);
        pg8::EpiDown E{Y16, Z16, (const pg8::f32x2*)st1, modb, bada, P.in[I_LN1G], P.in[I_LN1B]};
        pg8::gemm_phase<pg8::EpiDown, pg8::StaticOrder, true, true>(lds, g, S, E);
    }
    xcd_barrier(xbar);

    if constexpr ((PHASE_MASK >> 9) & 1) {
        PHASE_VARS
        f32x4 G2[4], B2[4];
#pragma unroll
        for (int j = 0; j < 4; ++j) { const int c = 4 * lane + 256 * j; G2[j] = *(const f32x4*)(P.in[I_LN2G] + c); B2[j] = *(const f32x4*)(P.in[I_LN2B] + c); }
        h16x4 pa[4], pb[4];
#define P9_LD(dst, r_) do { _Pragma("unroll") for (int j = 0; j < 4; ++j) dst[j] = __builtin_nontemporal_load((const h16x4*)(Z16 + (size_t)(r_) * DM + 4 * lane + 256 * j)); } while (0)
        if (gw < T_TOK) P9_LD(pa, gw);
        if (gw + NGW < T_TOK) P9_LD(pb, gw + NGW);
        for (int r = gw; r < T_TOK; r += NGW) {
            float* yr = Y + (size_t)r * DM;
            f32x4 v[4]; float s = 0.f;
#pragma unroll
            for (int j = 0; j < 4; ++j) { v[j] = __builtin_convertvector(pa[j], f32x4); pa[j] = pb[j]; s += (v[j][0] + v[j][1]) + (v[j][2] + v[j][3]); }
            if (r + 2 * NGW < T_TOK) P9_LD(pb, r + 2 * NGW);
            const float mean = wave_sum(s) * (1.0f / DM); float q = 0.f;
#pragma unroll
            for (int j = 0; j < 4; ++j) { const f32x4 d = v[j] - mean; q += (d[0] * d[0] + d[1] * d[1]) + (d[2] * d[2] + d[3] * d[3]); }
            const float rstd = 1.0f / sqrtf(wave_sum(q) * (1.0f / DM) + LN_EPS);
#pragma unroll
            for (int j = 0; j < 4; ++j) __builtin_nontemporal_store((v[j] - mean) * rstd * G2[j] + B2[j], (f32x4*)(yr + 4 * lane + 256 * j));
        }
#undef P9_LD
    }
}

extern "C" void kernel_launch(void* const* d_in, const int* in_sizes, int n_in, void* d_out, int out_size, void* d_ws, size_t ws_size, hipStream_t stream) {
    static int grid = 0;
    if (grid == 0) {
        if (n_in != 22 || out_size != T_TOK * DM || ws_size < WS_END) { fprintf(stderr, "kernel_launch: unexpected shapes (n_in %d, out %d, ws %zu)\n", n_in, out_size, ws_size); grid = -1; return; }
        int dev = 0, cus = 0, per_cu = 0;
        hipGetDevice(&dev);
        hipDeviceGetAttribute(&cus, hipDeviceAttributeMultiprocessorCount, dev);
        if (hipFuncSetAttribute((const void*)mega_fwd, hipFuncAttributeMaxDynamicSharedMemorySize, LDS_BYTES) != hipSuccess) { fprintf(stderr, "kernel_launch: hipFuncSetAttribute failed\n"); grid = -1; return; }
        if (hipOccupancyMaxActiveBlocksPerMultiprocessor(&per_cu, (const void*)mega_fwd, NWAVES * 64, LDS_BYTES) != hipSuccess || per_cu < 1) { fprintf(stderr, "kernel_launch: occupancy query failed (%d)\n", per_cu); per_cu = 1; }
        (void)hipGetLastError();
        grid = cus * per_cu;
        if (grid > 256) grid = 256;
        if (grid % 8) grid -= grid % 8;
        if (grid < 8) grid = 8;
    }
    if (grid < 0) return;
    hipMemsetAsync((char*)d_ws + WS_MOD, 0, WS_ZERO_BYTES, stream);
    Params p{};
    for (int i = 0; i < 22; ++i) p.in[i] = (const float*)d_in[i];
    p.out = (float*)d_out; p.ws = (unsigned char*)d_ws;
    void* args[] = {&p};
    hipError_t e = hipLaunchCooperativeKernel((const void*)mega_fwd, dim3(grid), dim3(NWAVES * 64), args, LDS_BYTES, stream);
    if (e != hipSuccess) fprintf(stderr, "kernel_launch: cooperative launch failed: %s (grid %d)\n", hipGetErrorString(e), grid);
}
```

```cpp
#include <hip/hip_runtime.h>
#include <hip/hip_cooperative_groups.h>
#include <cstdio>
#include <cstdint>
namespace cg = cooperative_groups;
namespace pg8 {
#define PG8_LAS __attribute__((address_space(3)))
typedef unsigned short bf16_t;
typedef short bf16x8 __attribute__((ext_vector_type(8)));
typedef float f32x4 __attribute__((ext_vector_type(4)));
typedef unsigned u32x4 __attribute__((ext_vector_type(4)));
constexpr int BM = 256, BK = 64, HALF = 128, HTB = HALF * BK * 2  , STAGE_BYTES = 8 * HTB, NXCD = 8, WGM = 4;

__host__ __device__ __forceinline__ int lds_byte(int r, int c) { const int st = (r >> 4) * 2 + (c >> 5), rr = r & 15, cc = c & 31, ob = rr * 64 + cc * 2; return st * 1024 + (ob ^ (((ob >> 9) & 1) << 5)); }
__host__ __device__ __forceinline__ void stage_rc(int b, int& R, int& C) { const int st = b / 1024, sb = b % 1024, swz = sb ^ (((sb >> 9) & 1) << 5); R = (st >> 1) * 16 + swz / 64; C = (st & 1) * 32 + (swz % 64) / 2; }
__host__ __device__ __forceinline__ int perm32(int rho) { const int n = rho >> 4, i = rho & 15; return 8 * (i >> 2) + 4 * n + (i & 3); }

struct Unit { int pm, pn; };
struct Gemm { const bf16_t* A; const bf16_t* Bt; int M, N, K; };

struct StaticOrder {
    int nM, nN, nwg, G, c;
    __host__ __device__ void init(int M, int N, int G_, int c_) { nM = M / BM; nN = N / BM; nwg = nM * nN; G = G_; c = c_; }
    __host__ __device__ bool next(int i, Unit& u) const {
        const long L = (long)i * G + c; if (L >= nwg) return false;
        int wgid = (int)L; { const int q = nwg / NXCD, r = nwg % NXCD, xcd = wgid % NXCD, off = wgid / NXCD; wgid = (xcd < r ? xcd * (q + 1) : r * (q + 1) + (xcd - r) * q) + off; }
        const int nig = WGM * nN, gid = wgid / nig, fm = gid * WGM, gsz = (nM - fm) < WGM ? (nM - fm) : WGM;
        u.pm = fm + ((wgid % nig) % gsz); u.pn = (wgid % nig) / gsz; return true;
    }
    __device__ __forceinline__ void a_ready(const Unit&) const {}
    __device__ __forceinline__ void done(const Unit&) const {}
};

__device__ __forceinline__ unsigned cvt_pk_bf16(float lo, float hi) { unsigned r; asm volatile("v_cvt_pk_bf16_f32 %0, %1, %2" : "=v"(r) : "v"(lo), "v"(hi)); return r; }
typedef float f32x2 __attribute__((ext_vector_type(2)));
template <class Epi, class Sched, bool ALIGN_EPI = false, bool SP2 = false>
__device__ __forceinline__ void gemm_phase(PG8_LAS unsigned char* lds, const Gemm g, const Sched& S, const Epi& E) {
    int tid_l = threadIdx.x; asm volatile("" : "+v"(tid_l));
    const int tid = tid_l, wid = __builtin_amdgcn_readfirstlane(tid >> 6), lane = tid & 63, wr = wid >> 2, wc = wid & 3, fr = lane & 15, fq = lane >> 4;
    const int K = g.K, nt = K / BK;
    unsigned voffA[2], voffB[2];
#pragma unroll
    for (int i = 0; i < 2; ++i) { int R, C; stage_rc(tid * 16 + i * 8192, R, C); const int Rb = Epi::PERM ? ((R & ~31) + perm32(R & 31)) : R;
        voffA[i] = (unsigned)(R * K + C) * 2u; voffB[i] = (unsigned)(Rb * K + C) * 2u; }
    const size_t kstep = (size_t)(BK * 2);
    const size_t hstep = (size_t)HALF * K * 2;
    const size_t tstep = 2 * hstep;
    const unsigned ldsw = (unsigned)wid * 1024u;
    const int aoff = lds_byte(wr * 64 + fr, fq * 8), boff = lds_byte(wc * 32 + fr, fq * 8);
#define PG8_SA(b, h) (((b) * 2 + (h)) * HTB)
#define PG8_SB(b, h) ((4 + (b) * 2 + (h)) * HTB)
#define PG8_STAGE(bufoff, gbase, voff) do { _Pragma("unroll") for (int _i = 0; _i < 2; ++_i) \
        __builtin_amdgcn_global_load_lds((const unsigned*)((const char*)(gbase) + (voff)[_i]), (PG8_LAS unsigned*)(lds + (bufoff) + ldsw + _i * 8192), 16, 0, 0); } while (0)
#define PG8_LDA(dst, b, h) do { _Pragma("unroll") for (int m = 0; m < 4; ++m) _Pragma("unroll") for (int k = 0; k < 2; ++k) dst[m][k] = *(const PG8_LAS bf16x8*)(lds + PG8_SA(b, h) + aoff + m * 2048 + k * 1024); } while (0)
#define PG8_LDB(dst, b, h) do { _Pragma("unroll") for (int n = 0; n < 2; ++n) _Pragma("unroll") for (int k = 0; k < 2; ++k) dst[n][k] = *(const PG8_LAS bf16x8*)(lds + PG8_SB(b, h) + boff + n * 2048 + k * 1024); } while (0)
#define PG8_MMA(ai, bj, At, Bt) do { __builtin_amdgcn_s_setprio(1); _Pragma("unroll") for (int m = 0; m < 4; ++m) _Pragma("unroll") for (int n = 0; n < 2; ++n) _Pragma("unroll") for (int k = 0; k < 2; ++k) \
        acc[ai][bj][m][n] = __builtin_amdgcn_mfma_f32_16x16x32_bf16(Bt[n][k], At[m][k], acc[ai][bj][m][n], 0, 0, 0); __builtin_amdgcn_s_setprio(0); } while (0)
#define PG8_WAIT_V(n) asm volatile("s_waitcnt vmcnt(" #n ")" ::: "memory")
#define PG8_WAIT_L(n) asm volatile("s_waitcnt lgkmcnt(" #n ")" ::: "memory")
#define PG8_BAR __builtin_amdgcn_s_barrier()
#define PG8_SCHED __builtin_amdgcn_sched_barrier(0)
    Unit cur, nxt; int ui = 0;
    if (!S.next(0, cur)) return;
    f32x4 acc[2][2][4][2];
#pragma unroll
    for (int a = 0; a < 2; ++a)
#pragma unroll
        for (int b = 0; b < 2; ++b)
#pragma unroll
            for (int m = 0; m < 4; ++m)
#pragma unroll
                for (int n = 0; n < 2; ++n) acc[a][b][m][n] = (f32x4){0.f, 0.f, 0.f, 0.f};
    bf16x8 At[4][2], B0[2][2], B1[2][2];
    const char* cA = (const char*)g.A + (size_t)cur.pm * tstep; const char* cB = (const char*)g.Bt + (size_t)cur.pn * tstep;
    S.a_ready(cur);
    if constexpr (SP2) {
        PG8_STAGE(PG8_SB(0, 0), cB, voffB); PG8_STAGE(PG8_SB(0, 1), cB + hstep, voffB); PG8_STAGE(PG8_SA(0, 0), cA, voffA); PG8_STAGE(PG8_SA(0, 1), cA + hstep, voffA);
        if (wr == 1) PG8_BAR;
        PG8_WAIT_V(2); PG8_BAR;
        PG8_STAGE(PG8_SB(1, 0), cB + kstep, voffB); PG8_STAGE(PG8_SA(1, 0), cA + kstep, voffA); PG8_STAGE(PG8_SB(1, 1), cB + hstep + kstep, voffB);
        PG8_WAIT_V(6); PG8_BAR;
    } else {
        PG8_STAGE(PG8_SB(0, 0), cB, voffB); PG8_STAGE(PG8_SA(0, 0), cA, voffA); PG8_STAGE(PG8_SB(0, 1), cB + hstep, voffB); PG8_STAGE(PG8_SA(0, 1), cA + hstep, voffA);
        if (wr == 1) PG8_BAR;
        PG8_WAIT_V(4); PG8_BAR;
        PG8_STAGE(PG8_SB(1, 0), cB + kstep, voffB); PG8_STAGE(PG8_SA(1, 0), cA + kstep, voffA); PG8_STAGE(PG8_SB(1, 1), cB + hstep + kstep, voffB);
        PG8_WAIT_V(6); PG8_BAR;
    }
    for (;;) {
        const bool has_next = S.next(ui + 1, nxt);
        const char* nA = has_next ? (const char*)g.A + (size_t)nxt.pm * tstep : cA; const char* nB = has_next ? (const char*)g.Bt + (size_t)nxt.pn * tstep : cB;
        for (int t = 0; t < nt; t += 2) {
            if constexpr (Epi::HAS_MID) { if (t == (nt >> 1)) E.mid(acc, cur, wr, wc, fr, fq); }
            const bool last = (t == nt - 2);
            const char* a1 = cA + (size_t)(t + 1) * kstep;
            const char* a2 = last ? nA : cA + (size_t)(t + 2) * kstep; const char* b2 = last ? nB : cB + (size_t)(t + 2) * kstep;
            const char* a3 = a2 + kstep; const char* b3 = b2 + kstep;
            if (last && has_next) S.a_ready(nxt);
            if constexpr (SP2) {
            PG8_LDB(B0, 0, 0); PG8_LDB(B1, 0, 1); PG8_SCHED; PG8_LDA(At, 0, 0); PG8_STAGE(PG8_SA(1, 1), a1 + hstep, voffA);
            PG8_WAIT_V(8); PG8_WAIT_L(0); PG8_BAR; PG8_MMA(0, 0, At, B0); PG8_MMA(0, 1, At, B1); PG8_BAR; PG8_SCHED;
            PG8_LDA(At, 0, 1); PG8_STAGE(PG8_SB(0, 0), b2, voffB); PG8_STAGE(PG8_SB(0, 1), b2 + hstep, voffB); PG8_STAGE(PG8_SA(0, 0), a2, voffA);
            PG8_WAIT_V(8); PG8_WAIT_L(0); PG8_BAR; PG8_MMA(1, 0, At, B0); PG8_MMA(1, 1, At, B1); PG8_BAR; PG8_SCHED;
            PG8_LDB(B0, 1, 0); PG8_LDB(B1, 1, 1); PG8_SCHED; PG8_LDA(At, 1, 0); PG8_STAGE(PG8_SA(0, 1), a2 + hstep, voffA);
            PG8_WAIT_V(8); PG8_WAIT_L(0); PG8_BAR; PG8_MMA(0, 0, At, B0); PG8_MMA(0, 1, At, B1); PG8_BAR; PG8_SCHED;
            PG8_LDA(At, 1, 1); PG8_STAGE(PG8_SB(1, 0), b3, voffB); PG8_STAGE(PG8_SB(1, 1), b3 + hstep, voffB); PG8_STAGE(PG8_SA(1, 0), a3, voffA);
            PG8_WAIT_V(8); PG8_WAIT_L(0); PG8_BAR; PG8_MMA(1, 0, At, B0); PG8_MMA(1, 1, At, B1); PG8_BAR; PG8_SCHED;
            } else {
            PG8_LDB(B0, 0, 0); PG8_SCHED; PG8_LDA(At, 0, 0); PG8_STAGE(PG8_SA(1, 1), a1 + hstep, voffA);
            PG8_WAIT_L(8); PG8_BAR; PG8_WAIT_L(0); PG8_MMA(0, 0, At, B0); PG8_BAR; PG8_SCHED;
            PG8_LDB(B1, 0, 1); PG8_STAGE(PG8_SB(0, 0), b2, voffB);
            PG8_BAR; PG8_WAIT_L(0); PG8_MMA(0, 1, At, B1); PG8_BAR;
            PG8_LDA(At, 0, 1); PG8_STAGE(PG8_SA(0, 0), a2, voffA);
            PG8_BAR; PG8_WAIT_L(0); PG8_MMA(1, 0, At, B0); PG8_BAR; PG8_SCHED;
            PG8_STAGE(PG8_SB(0, 1), b2 + hstep, voffB);
            PG8_WAIT_V(6); PG8_BAR; PG8_MMA(1, 1, At, B1); PG8_BAR;
            PG8_LDB(B0, 1, 0); PG8_SCHED; PG8_LDA(At, 1, 0); PG8_STAGE(PG8_SA(0, 1), a2 + hstep, voffA);
            PG8_WAIT_L(8); PG8_BAR; PG8_WAIT_L(0); PG8_MMA(0, 0, At, B0); PG8_BAR; PG8_SCHED;
            PG8_LDB(B1, 1, 1); PG8_STAGE(PG8_SB(1, 0), b3, voffB);
            PG8_BAR; PG8_WAIT_L(0); PG8_MMA(0, 1, At, B1); PG8_BAR;
            PG8_LDA(At, 1, 1); PG8_STAGE(PG8_SA(1, 0), a3, voffA);
            PG8_BAR; PG8_WAIT_L(0); PG8_MMA(1, 0, At, B0); PG8_BAR; PG8_SCHED;
            PG8_STAGE(PG8_SB(1, 1), b3 + hstep, voffB);
            PG8_WAIT_V(6); PG8_BAR; PG8_MMA(1, 1, At, B1); PG8_BAR;
            }
        }
        if constexpr (ALIGN_EPI) { if (wr == 0) PG8_BAR; }
        if constexpr (!Epi::AFTER_DRAIN) { E(acc, cur, wr, wc, fr, fq);
#ifdef PROBE_EPI_TWICE
            if constexpr (Epi::PERM == (PROBE_EPI_TWICE == 1)) { asm volatile("" ::: "memory"); E(acc, cur, wr, wc, fr, fq); }
#endif
            S.done(cur); }
        if (!has_next) break;
#pragma unroll
        for (int a = 0; a < 2; ++a)
#pragma unroll
            for (int b = 0; b < 2; ++b)
#pragma unroll
                for (int m = 0; m < 4; ++m)
#pragma unroll
                    for (int n = 0; n < 2; ++n) acc[a][b][m][n] = (f32x4){0.f, 0.f, 0.f, 0.f};
        cur = nxt; cA = nA; cB = nB; ++ui;
        if constexpr (ALIGN_EPI) { if (wr == 1) PG8_BAR; }
    }
    PG8_WAIT_V(0);
    if constexpr (!ALIGN_EPI) { if (wr == 0) PG8_BAR; }
    PG8_BAR;
    if constexpr (Epi::AFTER_DRAIN) { E.fused(acc, cur, wr, wc, fr, fq, lds, wid, lane); S.done(cur); }
#undef PG8_SA
#undef PG8_SB
#undef PG8_STAGE
#undef PG8_LDA
#undef PG8_LDB
#undef PG8_MMA
#undef PG8_WAIT_V
#undef PG8_WAIT_L
#undef PG8_BAR
#undef PG8_SCHED
}
}

constexpr int T_TOK = 81920, DM = 1024, NPROJ = 4352, DFF = 2816, SEQ = 4096, NBATCH = 20, PROMPT_TILES = 256  ;
constexpr int MODN = 6 * DM;
constexpr float ALPHA_RES = 1.189207115002721f;
constexpr float LOG2E = 1.4426950408889634f;
constexpr float QSCALE = 0.125f * LOG2E;
constexpr float LN_EPS = 1e-5f;
#define LAS __attribute__((address_space(3)))
typedef unsigned u32x2 __attribute__((ext_vector_type(2)));
typedef _Float16 h16x4 __attribute__((ext_vector_type(4)));
typedef _Float16 h16_t;

__device__ __forceinline__ float bf_lo(unsigned w) { return __uint_as_float(w << 16); }
__device__ __forceinline__ float bf_hi(unsigned w) { return __uint_as_float(w & 0xffff0000u); }
__device__ __forceinline__ float sigmoidf_fast(float v) { return __builtin_amdgcn_rcpf(1.0f + __builtin_amdgcn_exp2f(-v * LOG2E)); }

namespace pg8 {
struct EpiProj {
    static constexpr bool PERM = true, AFTER_DRAIN = false, HAS_MID = false;
    bf16_t* O; const float* cosT; const float* sinT;
    __device__ __forceinline__ void operator()(const f32x4 (&acc)[2][2][4][2], const Unit& u, int wr, int wc, int fr, int fq) const {
        const int row0 = u.pm * BM + wr * 64 + fr;
#pragma unroll
        for (int bj = 0; bj < 2; ++bj) {
            const int c128 = 2 * u.pn + bj;
            const int mode = (c128 < 4 || (c128 >= 6 && c128 < 10)) ? 1 : ((c128 == 4 || (c128 >= 10 && c128 < 14)) ? 2 : (c128 >= 18 ? 3 : 0));
            const int col0 = c128 * 128 + wc * 32 + 8 * fq;
            const int i0 = 16 * (wc & 1) + 4 * fq;
#pragma unroll
            for (int ai = 0; ai < 2; ++ai)
#pragma unroll
                for (int m = 0; m < 4; ++m) {
                    const int row = row0 + ai * HALF + m * 16;
                    f32x4 v0 = acc[ai][bj][m][0], v1 = acc[ai][bj][m][1];
                    if (mode == 1 || mode == 2) {
                        const int pos = row & (SEQ - 1);
                        const f32x4 c = *(const f32x4*)(cosT + pos * 32 + i0), s = *(const f32x4*)(sinT + pos * 32 + i0);
                        f32x4 a, b;
                        a[0] = v0[0] * c[0] - v0[1] * s[0]; a[1] = v0[1] * c[0] + v0[0] * s[0];
                        a[2] = v0[2] * c[1] - v0[3] * s[1]; a[3] = v0[3] * c[1] + v0[2] * s[1];
                        b[0] = v1[0] * c[2] - v1[1] * s[2]; b[1] = v1[1] * c[2] + v1[0] * s[2];
                        b[2] = v1[2] * c[3] - v1[3] * s[3]; b[3] = v1[3] * c[3] + v1[2] * s[3];
                        if (mode == 1) { a = a * QSCALE; b = b * QSCALE; }
                        v0 = a; v1 = b;
                    } else if (mode == 3) {
#pragma unroll
                        for (int j = 0; j < 4; ++j) { v0[j] = sigmoidf_fast(v0[j]); v1[j] = sigmoidf_fast(v1[j]); }
                    }
                    u32x4 w; w.x = cvt_pk_bf16(v0[0], v0[1]); w.y = cvt_pk_bf16(v0[2], v0[3]); w.z = cvt_pk_bf16(v1[0], v1[1]); w.w = cvt_pk_bf16(v1[2], v1[3]);
                    *(u32x4*)(O + (size_t)row * NPROJ + col0) = w;
                }
        }
    }
};
struct EpiMerge {
    static constexpr bool PERM = true, AFTER_DRAIN = false, HAS_MID = true;
    const bf16_t* proj; bf16_t* O;
    __device__ __forceinline__ void mid(f32x4 (&acc)[2][2][4][2], const Unit& u, int wr, int wc, int fr, int fq) const {
        int row0 = u.pm * BM + wr * 64 + fr;
        asm volatile("" : "+v"(row0));
#pragma unroll
        for (int ai = 0; ai < 2; ++ai)
#pragma unroll
            for (int m = 0; m < 4; ++m)
#pragma unroll
                for (int bj = 0; bj < 2; ++bj) {
                    const size_t off = (size_t)(row0 + ai * HALF + m * 16) * NPROJ + 2304 + u.pn * BM + bj * HALF + wc * 32 + 8 * fq;
                    const u32x4 ga = *(const u32x4*)(proj + off), gb = *(const u32x4*)(proj + off + 1024);
                    f32x4 r0, r1;
                    r0[0] = bf_lo(ga.x) * __builtin_amdgcn_rcpf(bf_lo(gb.x)); r0[1] = bf_hi(ga.x) * __builtin_amdgcn_rcpf(bf_hi(gb.x));
                    r0[2] = bf_lo(ga.y) * __builtin_amdgcn_rcpf(bf_lo(gb.y)); r0[3] = bf_hi(ga.y) * __builtin_amdgcn_rcpf(bf_hi(gb.y));
                    r1[0] = bf_lo(ga.z) * __builtin_amdgcn_rcpf(bf_lo(gb.z)); r1[1] = bf_hi(ga.z) * __builtin_amdgcn_rcpf(bf_hi(gb.z));
                    r1[2] = bf_lo(ga.w) * __builtin_amdgcn_rcpf(bf_lo(gb.w)); r1[3] = bf_hi(ga.w) * __builtin_amdgcn_rcpf(bf_hi(gb.w));
                    acc[ai][bj][m][0] = acc[ai][bj][m][0] * r0; acc[ai][bj][m][1] = acc[ai][bj][m][1] * r1;
                    if (bj == 1 && (m & 1)) asm volatile("" : "+v"(acc[ai][bj][m][0]), "+v"(acc[ai][bj][m][1]) :: "memory");
                }
    }
    __device__ __forceinline__ void operator()(const f32x4 (&acc)[2][2][4][2], const Unit& u, int wr, int wc, int fr, int fq) const {
        const int row0 = u.pm * BM + wr * 64 + fr;
#pragma unroll
        for (int ai = 0; ai < 2; ++ai)
#pragma unroll
            for (int m = 0; m < 4; ++m)
#pragma unroll
                for (int bj = 0; bj < 2; ++bj) {
                    const int row = row0 + ai * HALF + m * 16, col0 = u.pn * BM + bj * HALF + wc * 32 + 8 * fq;
                    const u32x4 gb = *(const u32x4*)(proj + (size_t)row * NPROJ + 3328 + col0);
                    const f32x4 a = acc[ai][bj][m][0], b = acc[ai][bj][m][1];
                    u32x4 w;
                    w.x = cvt_pk_bf16(a[0] * bf_lo(gb.x), a[1] * bf_hi(gb.x)); w.y = cvt_pk_bf16(a[2] * bf_lo(gb.y), a[3] * bf_hi(gb.y));
                    w.z = cvt_pk_bf16(b[0] * bf_lo(gb.z), b[1] * bf_hi(gb.z)); w.w = cvt_pk_bf16(b[2] * bf_lo(gb.w), b[3] * bf_hi(gb.w));
                    *(u32x4*)(O + (size_t)row * DM + col0) = w;
                    if (bj == 1 && (m & 1)) asm volatile("" ::: "memory");
                }
    }
};
struct EpiWo {
    static constexpr bool PERM = false, AFTER_DRAIN = false, HAS_MID = false;
    const float* xp; const float* xs; const float* mod; const float* bada; h16_t* Y;
    __device__ __forceinline__ void operator()(const f32x4 (&acc)[2][2][4][2], const Unit& u, int wr, int wc, int fr, int fq) const {
        const int b = u.pm >> 4;
        const float* xbase = (u.pm < PROMPT_TILES) ? xp + (size_t)u.pm * BM * DM : xs + (size_t)(u.pm - PROMPT_TILES) * BM * DM;
        h16_t* ybase = Y + (size_t)u.pm * BM * DM;
#pragma unroll
        for (int bj = 0; bj < 2; ++bj)
#pragma unroll
            for (int n = 0; n < 2; ++n) {
                const int col = u.pn * BM + bj * HALF + wc * 32 + n * 16 + 4 * fq;
                const f32x4 gate = *(const f32x4*)(mod + b * MODN + 2 * DM + col) + *(const f32x4*)(bada + 2 * DM + col);
#pragma unroll
                for (int ai = 0; ai < 2; ++ai)
#pragma unroll
                    for (int m = 0; m < 4; ++m) {
                        const size_t off = (size_t)(ai * HALF + wr * 64 + m * 16 + fr) * DM + col;
                        const f32x4 xv = *(const f32x4*)(xbase + off);
                        *(h16x4*)(ybase + off) = __builtin_convertvector(xv * ALPHA_RES + gate * acc[ai][bj][m][n], h16x4);
                    }
            }
    }
};
struct EpiGU {
    static constexpr bool PERM = true, AFTER_DRAIN = false, HAS_MID = false;
    bf16_t* Hd;
    __device__ __forceinline__ void operator()(const f32x4 (&acc)[2][2][4][2], const Unit& u, int wr, int wc, int fr, int fq) const {
        const int row0 = u.pm * BM + wr * 64 + fr, hcol = u.pn * HALF + wc * 32 + 8 * fq;
#pragma unroll
        for (int ai = 0; ai < 2; ++ai)
#pragma unroll
            for (int m = 0; m < 4; ++m) {
                const int row = row0 + ai * HALF + m * 16;
                float a[8];
#pragma unroll
                for (int n = 0; n < 2; ++n)
#pragma unroll
                    for (int j = 0; j < 4; ++j) { const float g = acc[ai][0][m][n][j]; a[4 * n + j] = g * acc[ai][1][m][n][j] * sigmoidf_fast(g); }
                u32x4 w; w.x = cvt_pk_bf16(a[0], a[1]); w.y = cvt_pk_bf16(a[2], a[3]); w.z = cvt_pk_bf16(a[4], a[5]); w.w = cvt_pk_bf16(a[6], a[7]);
                *(u32x4*)(Hd + (size_t)row * DFF + hcol) = w;
            }
    }
};
struct EpiDown {
    static constexpr bool PERM = false, AFTER_DRAIN = false, HAS_MID = false;
    const h16_t* Y; h16_t* Z; const f32x2* st1; const float* mod; const float* bada; const float* g1; const float* b1;
    __device__ __forceinline__ void operator()(const f32x4 (&acc)[2][2][4][2], const Unit& u, int wr, int wc, int fr, int fq) const {
        const int b = u.pm >> 4;
        h16_t* zbase = Z + (size_t)u.pm * BM * DM; const h16_t* ybase = Y + (size_t)u.pm * BM * DM;
        const f32x2* sb = st1 + (size_t)u.pm * BM;
#pragma unroll
        for (int bj = 0; bj < 2; ++bj)
#pragma unroll
            for (int n = 0; n < 2; ++n) {
                const int col = u.pn * BM + bj * HALF + wc * 32 + n * 16 + 4 * fq;
                const f32x4 gate = *(const f32x4*)(mod + b * MODN + 5 * DM + col) + *(const f32x4*)(bada + 5 * DM + col);
                const f32x4 gv = *(const f32x4*)(g1 + col) * ALPHA_RES, bv = *(const f32x4*)(b1 + col) * ALPHA_RES;
#pragma unroll
                for (int ai = 0; ai < 2; ++ai)
#pragma unroll
                    for (int m = 0; m < 4; ++m) {
                        const int r = ai * HALF + wr * 64 + m * 16 + fr;
                        const f32x2 st = sb[r];
                        const size_t off = (size_t)r * DM + col;
                        const f32x4 yv = __builtin_convertvector(*(const h16x4*)(ybase + off), f32x4);
                        *(h16x4*)(zbase + off) = __builtin_convertvector((yv - st.x) * st.y * gv + bv + gate * acc[ai][bj][m][n], h16x4);
                    }
            }
    }
};
}

namespace att {
using pg8::bf16_t;
typedef short bf16x8 __attribute__((ext_vector_type(8)));
typedef short s16x4 __attribute__((ext_vector_type(4)));
typedef float f32x16 __attribute__((ext_vector_type(16)));
typedef float f32x4 __attribute__((ext_vector_type(4)));
typedef unsigned u32x4 __attribute__((ext_vector_type(4)));
constexpr int KP = 144;
constexpr int KBUF = 64 * KP;
constexpr int OFF_V = 2 * KBUF;
constexpr int VBUF_MAX = 64 * (128 * 2 + 64);
constexpr int OFF_FLAG = OFF_V + 3 * VBUF_MAX;
constexpr int OFF_ST = 0;
constexpr int STP = 272;
constexpr int ST_W = 32 * STP;
constexpr int ATT_LDS = OFF_FLAG + 16;
static_assert(8 * ST_W <= OFF_FLAG, "staging fits under the flag word");
__device__ __forceinline__ int crow(int r, int hi) { return (r & 3) + 8 * (r >> 2) + 4 * hi; }
__device__ __forceinline__ s16x4 vtr(LAS const char* p) { return __builtin_bit_cast(s16x4, __builtin_amdgcn_ds_read_tr16_b64_v4i16((LAS s16x4*)p)); }
__device__ __forceinline__ unsigned cvtpk(float lo, float hi) { return pg8::cvt_pk_bf16(lo, hi); }

template <int DV, bool WIN>
__device__ __forceinline__ void flash_robust(LAS char* lds, const bf16_t* Qrow, const bf16_t* Kg, const bf16_t* Vg, int t0, int t1, int qpos,
                                           float m_init, float l_init, bool first, f32x16 (&o)[DV / 32], float& l_out) {
    int tid_l = threadIdx.x; asm volatile("" : "+v"(tid_l)); const int tid = tid_l, lane = tid & 63, r32 = lane & 31, hi = lane >> 5;
    constexpr int VP = DV * 2 + 64, VBUF = 64 * VP, NVC = DV / 64;
    bf16x8 qf[4];
#pragma unroll
    for (int d0 = 0; d0 < 4; ++d0) qf[d0] = *(const bf16x8*)(Qrow + d0 * 16 + hi * 8);
    const int krow = tid >> 3, kch = tid & 7;
    const bf16_t* kg = Kg + (size_t)krow * NPROJ + kch * 8;
    const int kl = krow * KP + kch * 16;
    const int vrow = (DV == 128) ? (tid >> 4) : (tid >> 3), vch = (DV == 128) ? (tid & 15) : (tid & 7);
    const bf16_t* vg = Vg + (size_t)vrow * NPROJ + vch * 8;
    const int vl = OFF_V + vrow * VP + vch * 16;
    u32x4 kreg, vreg[NVC];
    kreg = *(const u32x4*)(kg + (size_t)t0 * 64 * NPROJ);
#pragma unroll
    for (int i = 0; i < NVC; ++i) vreg[i] = *(const u32x4*)(vg + (size_t)(t0 * 64 + 32 * i) * NPROJ);
    __syncthreads();
    *(LAS u32x4*)(lds + kl) = kreg;
#pragma unroll
    for (int i = 0; i < NVC; ++i) *(LAS u32x4*)(lds + vl + i * 32 * VP) = vreg[i];
    __syncthreads();
    float mref = m_init, lsum = (hi == 0) ? l_init : 0.f;
#pragma unroll
    for (int blk = 0; blk < DV / 32; ++blk)
#pragma unroll
        for (int r = 0; r < 16; ++r) o[blk][r] = 0.f;
    const int kaddr = r32 * KP + hi * 16;
    const int vaddr = OFF_V + (4 * hi + ((lane & 15) >> 2)) * VP + (16 * ((lane >> 4) & 1) + 4 * (lane & 3)) * 2;
    for (int t = t0; t < t1; ++t) {
        const int cur = (t - t0) & 1;
        const bool more = (t + 1 < t1);
        if (more) {
            kreg = *(const u32x4*)(kg + (size_t)(t + 1) * 64 * NPROJ);
#pragma unroll
            for (int i = 0; i < NVC; ++i) vreg[i] = *(const u32x4*)(vg + (size_t)((t + 1) * 64 + 32 * i) * NPROJ);
        }
        LAS const char* Kc = lds + cur * KBUF + kaddr;
        LAS const char* Vc = lds + cur * VBUF + vaddr;
        f32x16 p0, p1;
#pragma unroll
        for (int r = 0; r < 16; ++r) { p0[r] = -mref; p1[r] = -mref; }
#pragma unroll
        for (int d0 = 0; d0 < 4; ++d0) {
            const bf16x8 k0 = *(LAS const bf16x8*)(Kc + d0 * 32), k1 = *(LAS const bf16x8*)(Kc + d0 * 32 + 32 * KP);
            p0 = __builtin_amdgcn_mfma_f32_32x32x16_bf16(k0, qf[d0], p0, 0, 0, 0);
            p1 = __builtin_amdgcn_mfma_f32_32x32x16_bf16(k1, qf[d0], p1, 0, 0, 0);
        }
        if (WIN) {
            const int kb = 64 * t + 4 * hi - qpos;
#pragma unroll
            for (int r = 0; r < 16; ++r) {
                const int d = kb + (r & 3) + 8 * (r >> 2);
                if (d > 128 || d < -128) p0[r] = -1e30f;
                if (d + 32 > 128 || d + 32 < -128) p1[r] = -1e30f;
            }
        }
        float rm = fmaxf(p0[0], p1[0]);
#pragma unroll
        for (int r = 1; r < 16; ++r) rm = fmaxf(rm, fmaxf(p0[r], p1[r]));
        rm = fmaxf(rm, __shfl_xor(rm, 32));
        if (first || __any(rm > 8.0f)) {
            const float dl = first ? rm : fmaxf(rm, 0.f);
            mref += dl;
#pragma unroll
            for (int r = 0; r < 16; ++r) { p0[r] -= dl; p1[r] -= dl; }
            if (!first) {
                const float al = __builtin_amdgcn_exp2f(-dl);
                lsum *= al;
#pragma unroll
                for (int blk = 0; blk < DV / 32; ++blk)
#pragma unroll
                    for (int r = 0; r < 16; ++r) o[blk][r] *= al;
            }
            first = false;
        }
        float s0 = 0.f, s1 = 0.f;
#pragma unroll
        for (int r = 0; r < 16; ++r) { p0[r] = __builtin_amdgcn_exp2f(p0[r]); p1[r] = __builtin_amdgcn_exp2f(p1[r]); s0 += p0[r]; s1 += p1[r]; }
        lsum += s0 + s1;
        bf16x8 pk[4];
        __builtin_amdgcn_sched_barrier(0);
#pragma unroll
        for (int c = 0; c < 2; ++c) {
            u32x4 w0, w1;
            w0.x = cvtpk(p0[8 * c + 0], p0[8 * c + 1]); w0.y = cvtpk(p0[8 * c + 2], p0[8 * c + 3]); w0.z = cvtpk(p0[8 * c + 4], p0[8 * c + 5]); w0.w = cvtpk(p0[8 * c + 6], p0[8 * c + 7]);
            w1.x = cvtpk(p1[8 * c + 0], p1[8 * c + 1]); w1.y = cvtpk(p1[8 * c + 2], p1[8 * c + 3]); w1.z = cvtpk(p1[8 * c + 4], p1[8 * c + 5]); w1.w = cvtpk(p1[8 * c + 6], p1[8 * c + 7]);
            pk[c] = __builtin_bit_cast(bf16x8, w0); pk[2 + c] = __builtin_bit_cast(bf16x8, w1);
        }
#pragma unroll
        for (int blk = 0; blk < DV / 32; ++blk)
#pragma unroll
            for (int c = 0; c < 4; ++c) {
                const s16x4 lo = vtr(Vc + c * 16 * VP + blk * 64), hh = vtr(Vc + c * 16 * VP + 8 * VP + blk * 64);
                const bf16x8 vf = (bf16x8){lo[0], lo[1], lo[2], lo[3], hh[0], hh[1], hh[2], hh[3]};
                o[blk] = __builtin_amdgcn_mfma_f32_32x32x16_bf16(vf, pk[c], o[blk], 0, 0, 0);
                if (c == 3) __builtin_amdgcn_sched_barrier(0);
            }
        if (more) {
            *(LAS u32x4*)(lds + (cur ^ 1) * KBUF + kl) = kreg;
#pragma unroll
            for (int i = 0; i < NVC; ++i) *(LAS u32x4*)(lds + (cur ^ 1) * VBUF + vl + i * 32 * VP) = vreg[i];
        }
        __syncthreads();
    }
    l_out = lsum + __shfl_xor(lsum, 32);
}

__device__ __forceinline__ float halfswap_add(float v) { auto rr = __builtin_amdgcn_permlane32_swap(__float_as_uint(v), __float_as_uint(v), false, false); return __uint_as_float(rr[0]) + __uint_as_float(rr[1]); }
template <int DV, bool WIN>
__device__ __forceinline__ void flash_fast(LAS char* lds, const bf16_t* Qrow, const bf16_t* Kg, const bf16_t* Vg, int t0, int t1, int qpos,
                                           float l_init, f32x16 (&o)[DV / 32], float& l_out) {
    int tid_l = threadIdx.x; asm volatile("" : "+v"(tid_l)); const int tid = tid_l, lane = tid & 63, r32 = lane & 31, hi = lane >> 5;
    constexpr int VP = DV * 2 + 64, VBUF = 64 * VP, NVC = DV / 64;
    bf16x8 qf[4];
#pragma unroll
    for (int d0 = 0; d0 < 4; ++d0) qf[d0] = *(const bf16x8*)(Qrow + d0 * 16 + hi * 8);
    const int krow = tid >> 3, kch = tid & 7;
    const bf16_t* kg = Kg + (size_t)krow * NPROJ + kch * 8;
    const int kl = krow * KP + kch * 16;
    const int vrow = (DV == 128) ? (tid >> 4) : (tid >> 3), vch = (DV == 128) ? (tid & 15) : (tid & 7);
    const bf16_t* vg = Vg + (size_t)vrow * NPROJ + vch * 8;
    const int vl = OFF_V + vrow * VP + vch * 16;
    const int kaddr = r32 * KP + hi * 16;
    const int vaddr = OFF_V + (4 * hi + ((lane & 15) >> 2)) * VP + (16 * ((lane >> 4) & 1) + 4 * (lane & 3)) * 2;
    u32x4 kreg, vreg[NVC];
    {
        const int tn = (t0 + 1 < t1) ? t0 + 1 : t0;
        kreg = *(const u32x4*)(kg + (size_t)t0 * 64 * NPROJ);
        const u32x4 k2 = *(const u32x4*)(kg + (size_t)tn * 64 * NPROJ);
#pragma unroll
        for (int i = 0; i < NVC; ++i) vreg[i] = *(const u32x4*)(vg + (size_t)(t0 * 64 + 32 * i) * NPROJ);
        __syncthreads();
        *(LAS u32x4*)(lds + kl) = kreg; *(LAS u32x4*)(lds + KBUF + kl) = k2;
#pragma unroll
        for (int i = 0; i < NVC; ++i) *(LAS u32x4*)(lds + vl + i * 32 * VP) = vreg[i];
        __syncthreads();
    }
    f32x16 sc0, sc1;
    const f32x16 zero16 = {0.f, 0.f, 0.f, 0.f, 0.f, 0.f, 0.f, 0.f, 0.f, 0.f, 0.f, 0.f, 0.f, 0.f, 0.f, 0.f};
#define ATT_QK(S0, S1, KOFF) do { \
        _Pragma("unroll") for (int d0 = 0; d0 < 4; ++d0) { \
            const bf16x8 k0_ = *(LAS const bf16x8*)(lds + (KOFF) + kaddr + d0 * 32), k1_ = *(LAS const bf16x8*)(lds + (KOFF) + kaddr + d0 * 32 + 32 * KP); \
            if (d0 == 0) { S0 = __builtin_amdgcn_mfma_f32_32x32x16_bf16(k0_, qf[0], zero16, 0, 0, 0); S1 = __builtin_amdgcn_mfma_f32_32x32x16_bf16(k1_, qf[0], zero16, 0, 0, 0); } \
            else { S0 = __builtin_amdgcn_mfma_f32_32x32x16_bf16(k0_, qf[d0], S0, 0, 0, 0); S1 = __builtin_amdgcn_mfma_f32_32x32x16_bf16(k1_, qf[d0], S1, 0, 0, 0); } } } while (0)
#define ATT_MASK(S0, S1, T) do { if (WIN) { const int kb_ = 64 * (T) + 4 * hi - qpos + 128; \
        _Pragma("unroll") for (int r = 0; r < 16; ++r) { const int d_ = kb_ + (r & 3) + 8 * (r >> 2); \
            if ((unsigned)d_ > 256u) S0[r] = -1e30f; if ((unsigned)(d_ + 32) > 256u) S1[r] = -1e30f; } } } while (0)
    ATT_QK(sc0, sc1, 0);
    __syncthreads();
#pragma unroll
    for (int blk = 0; blk < DV / 32; ++blk) o[blk] = zero16;
    u32x4 pp[4] = {{0u, 0u, 0u, 0u}, {0u, 0u, 0u, 0u}, {0u, 0u, 0u, 0u}, {0u, 0u, 0u, 0u}};
    float lsum = (hi == 0) ? l_init : 0.f;
    int kn = KBUF;
    int vp_ = 0, vc_ = 0, vn_ = VBUF;
    u32x4 kreg2, vreg2[NVC];
    { const int tk0 = (t0 + 2 < t1) ? t0 + 2 : t1 - 1, tv0 = (t0 + 1 < t1) ? t0 + 1 : t1 - 1;
      kreg2 = *(const u32x4*)(kg + (size_t)tk0 * 64 * NPROJ);
#pragma unroll
      for (int i = 0; i < NVC; ++i) vreg2[i] = *(const u32x4*)(vg + (size_t)(tv0 * 64 + 32 * i) * NPROJ); }
    f32x16 sd0, sd1;
    constexpr int NB = DV / 32, NSL = 4 * NB, EPS = 32 / NSL;
    s16x4 vfr[8]; bf16x8 kf[4];
#pragma unroll
    for (int j = 0; j < 8; ++j) vfr[j] = vtr(lds + vp_ + vaddr + (j >> 1) * 16 * VP + (j & 1) * 8 * VP);
#define ATT_SV(S0, S1, i) ((i) < 16 ? S0[(i) & 15] : S1[(i) & 15])
#define ATT_VF(s) ((bf16x8){vfr[(2 * (s)) & 7][0], vfr[(2 * (s)) & 7][1], vfr[(2 * (s)) & 7][2], vfr[(2 * (s)) & 7][3], vfr[(2 * (s) + 1) & 7][0], vfr[(2 * (s) + 1) & 7][1], vfr[(2 * (s) + 1) & 7][2], vfr[(2 * (s) + 1) & 7][3]})
#define ATT_STEP(SC0, SC1, SN0, SN1, T, KLD, VLD, KST, VST) do { \
        const int tk_ = ((T) + 3 < t1) ? (T) + 3 : t1 - 1, tv_ = ((T) + 2 < t1) ? (T) + 2 : t1 - 1; \
        ATT_MASK(SC0, SC1, (T)); \
        KLD = *(const u32x4*)(kg + (size_t)tk_ * 64 * NPROJ);     \
        _Pragma("unroll") for (int i = 0; i < NVC; ++i) VLD[i] = *(const u32x4*)(vg + (size_t)(tv_ * 64 + 32 * i) * NPROJ); \
        __builtin_amdgcn_sched_barrier(0); \
        _Pragma("unroll") for (int s_ = 0; s_ < NSL; ++s_) { \
            const int blk = s_ >> 2, c = s_ & 3; \
            o[blk] = __builtin_amdgcn_mfma_f32_32x32x16_bf16(ATT_VF(s_), __builtin_bit_cast(bf16x8, pp[c]), o[blk], 0, 0, 0); \
            if (s_ + 4 < NSL) { vfr[(2 * s_) & 7] = vtr(lds + vp_ + vaddr + c * 16 * VP + (blk + 1) * 64); vfr[(2 * s_ + 1) & 7] = vtr(lds + vp_ + vaddr + c * 16 * VP + 8 * VP + (blk + 1) * 64); } \
            else { const int j_ = s_ + 4 - NSL; kf[j_] = *(LAS const bf16x8*)(lds + kn + kaddr + (j_ >> 1) * 32 + (j_ & 1) * 32 * KP); } \
            _Pragma("unroll") for (int e = 0; e < EPS; ++e) { const int i_ = s_ * EPS + e; if (i_ < 16) SC0[i_ & 15] = __builtin_amdgcn_exp2f(SC0[i_ & 15]); else SC1[i_ & 15] = __builtin_amdgcn_exp2f(SC1[i_ & 15]); } \
            if (s_ > 0) { _Pragma("unroll") for (int e = 0; e < EPS; ++e) lsum += ATT_SV(SC0, SC1, (s_ - 1) * EPS + e); } \
            __builtin_amdgcn_sched_barrier(0); } \
        _Pragma("unroll") for (int j = 0; j < 8; ++j) { \
            const int d0 = j >> 1; \
            if ((j & 1) == 0) { if (d0 == 0) SN0 = __builtin_amdgcn_mfma_f32_32x32x16_bf16(kf[j & 3], qf[0], zero16, 0, 0, 0); else SN0 = __builtin_amdgcn_mfma_f32_32x32x16_bf16(kf[j & 3], qf[d0], SN0, 0, 0, 0); } \
            else { if (d0 == 0) SN1 = __builtin_amdgcn_mfma_f32_32x32x16_bf16(kf[j & 3], qf[0], zero16, 0, 0, 0); else SN1 = __builtin_amdgcn_mfma_f32_32x32x16_bf16(kf[j & 3], qf[d0], SN1, 0, 0, 0); } \
            if (j < 4) { const int j_ = j + 4; kf[j & 3] = *(LAS const bf16x8*)(lds + kn + kaddr + (j_ >> 1) * 32 + (j_ & 1) * 32 * KP); } \
            else { const int n_ = j - 4; vfr[2 * n_] = vtr(lds + vc_ + vaddr + n_ * 16 * VP); vfr[2 * n_ + 1] = vtr(lds + vc_ + vaddr + n_ * 16 * VP + 8 * VP); } \
            if (j == 0) { _Pragma("unroll") for (int e = 0; e < EPS; ++e) lsum += ATT_SV(SC0, SC1, (NSL - 1) * EPS + e); } \
            _Pragma("unroll") for (int w_ = 2 * j; w_ < 2 * j + 2; ++w_) { const int c = w_ >> 2, e = w_ & 3; \
                pp[c][e] = (c < 2) ? cvtpk(SC0[(8 * c + 2 * e) & 15], SC0[(8 * c + 2 * e + 1) & 15]) : cvtpk(SC1[(8 * (c - 2) + 2 * e) & 15], SC1[(8 * (c - 2) + 2 * e + 1) & 15]); } \
            __builtin_amdgcn_sched_barrier(0); } \
        *(LAS u32x4*)(lds + (kn ^ KBUF) + kl) = KST;              \
        _Pragma("unroll") for (int i = 0; i < NVC; ++i) *(LAS u32x4*)(lds + vn_ + vl + i * 32 * VP) = VST[i]; \
        __syncthreads(); \
        kn ^= KBUF; \
        { const int nx_ = ((T) == t0) ? 2 * VBUF : vp_; vp_ = vc_; vc_ = vn_; vn_ = nx_; } } while (0)
    for (int t = t0; t < t1; t += 2) {
        ATT_STEP(sc0, sc1, sd0, sd1, t, kreg, vreg, kreg2, vreg2);
        ATT_STEP(sd0, sd1, sc0, sc1, t + 1, kreg2, vreg2, kreg, vreg);
    }
#undef ATT_STEP
#pragma unroll
    for (int blk = 0; blk < DV / 32; ++blk)
#pragma unroll
        for (int c = 0; c < 4; ++c) {
            const s16x4 lo = vtr(lds + vp_ + vaddr + c * 16 * VP + blk * 64), hh = vtr(lds + vp_ + vaddr + c * 16 * VP + 8 * VP + blk * 64);
            const bf16x8 vf = (bf16x8){lo[0], lo[1], lo[2], lo[3], hh[0], hh[1], hh[2], hh[3]};
            o[blk] = __builtin_amdgcn_mfma_f32_32x32x16_bf16(vf, __builtin_bit_cast(bf16x8, pp[c]), o[blk], 0, 0, 0);
        }
    l_out = halfswap_add(lsum);
#undef ATT_QK
#undef ATT_MASK
#undef ATT_SV
#undef ATT_VF
}
__device__ __forceinline__ bool wg_any(LAS char* lds, bool bad) {
    LAS unsigned* flag = (LAS unsigned*)(lds + OFF_FLAG);
    __syncthreads();
    if (threadIdx.x == 0) *flag = 0u;
    __syncthreads();
    if (bad) *flag = 1u;
    __syncthreads();
    return *flag != 0u;
}
template <int NB> __device__ __forceinline__ bool pass_bad(const f32x16 (&o)[NB], float l) {
    float a = 0.f;
#pragma unroll
    for (int blk = 0; blk < NB; ++blk)
#pragma unroll
        for (int r = 0; r < 16; ++r) a += __builtin_fabsf(o[blk][r]);
    return !(l > 1e-30f && l < 1e30f && a < 1e30f);
}

__device__ __forceinline__ void diff_unit(LAS char* lds, int b, int h, int qb, const bf16_t* proj, bf16_t* aout, float* oscr, float lam_in, const float* subw) {
    const float lam = __builtin_bit_cast(float, __builtin_amdgcn_readfirstlane(__builtin_bit_cast(int, lam_in)));
    const size_t tok0 = (size_t)b * SEQ;
    f32x16 o[4]; float l;
#define DU_TID int tid_l = threadIdx.x; asm volatile("" : "+v"(tid_l)); const int tid = tid_l, lane = tid & 63, r32 = lane & 31, hi = lane >> 5, wid = __builtin_amdgcn_readfirstlane(tid >> 6); (void)hi; (void)r32; (void)wid;
#define DU_PTRS const int qrow = qb * 256 + wid * 32 + r32; const bf16_t* qp = proj + (tok0 + qrow) * NPROJ + 768 + h * 128; const bf16_t* kp = proj + tok0 * NPROJ + 1280 + h * 128; const bf16_t* vp = proj + tok0 * NPROJ + 1792 + h * 128;
    { DU_TID DU_PTRS
      flash_fast<128, false>(lds, qp, kp, vp, 0, SEQ / 64, 0, 0.f, o, l); }
    if (wg_any(lds, pass_bad<4>(o, l))) { DU_TID DU_PTRS flash_robust<128, false>(lds, qp, kp, vp, 0, SEQ / 64, 0, 0.f, 0.f, true, o, l); }
    {
        DU_TID
        f32x4* sc = (f32x4*)oscr + tid; asm volatile("" : "+v"(sc));
        const float inv = 1.0f / l;
#pragma unroll
        for (int blk = 0; blk < 4; ++blk)
#pragma unroll
            for (int g = 0; g < 4; ++g) sc[(blk * 4 + g) * 512] = (f32x4){o[blk][4 * g] * inv, o[blk][4 * g + 1] * inv, o[blk][4 * g + 2] * inv, o[blk][4 * g + 3] * inv};
    }
    { DU_TID DU_PTRS
      flash_fast<128, false>(lds, qp + 64, kp + 64, vp, 0, SEQ / 64, 0, 0.f, o, l); }
    if (wg_any(lds, pass_bad<4>(o, l))) { DU_TID DU_PTRS flash_robust<128, false>(lds, qp + 64, kp + 64, vp, 0, SEQ / 64, 0, 0.f, 0.f, true, o, l); }
    __syncthreads();
    DU_TID
    const float inv1 = lam / l;
    f32x4* sc = (f32x4*)oscr + tid; asm volatile("" : "+v"(sc));
    float ss = 0.f;
#pragma unroll
    for (int blk = 0; blk < 4; ++blk)
#pragma unroll
        for (int g = 0; g < 4; ++g) {
            const f32x4 a = sc[(blk * 4 + g) * 512];
#pragma unroll
            for (int j = 0; j < 4; ++j) { const float v = a[j] - o[blk][4 * g + j] * inv1; o[blk][4 * g + j] = v; ss += v * v; }
            if (g == 3) asm volatile("" : "+v"(ss) :: "memory");
        }
    ss += __shfl_xor(ss, 32);
    const float rs = __builtin_amdgcn_rsqf(ss * (1.0f / 128.0f) + 1e-5f) * 0.8f;
    LAS char* st = lds + OFF_ST + wid * ST_W;
#pragma unroll
    for (int blk = 0; blk < 4; ++blk)
#pragma unroll
        for (int g = 0; g < 4; ++g) {
            const int dv = 32 * blk + 8 * g + 4 * hi;
            const f32x4 w = *(const f32x4*)(subw + dv);
            u32x2 pw; pw.x = cvtpk(o[blk][4 * g] * rs * w[0], o[blk][4 * g + 1] * rs * w[1]); pw.y = cvtpk(o[blk][4 * g + 2] * rs * w[2], o[blk][4 * g + 3] * rs * w[3]);
            *(LAS u32x2*)(st + r32 * STP + dv * 2) = pw;
            if (g == 3) asm volatile("" ::: "memory");
        }
    bf16_t* ob = aout + (tok0 + qb * 256 + wid * 32) * DM + 512 + h * 128;
#pragma unroll
    for (int i = 0; i < 8; ++i) {
        const int idx = i * 64 + lane, row = idx >> 4, ch = idx & 15;
        const u32x4 v = *(LAS const u32x4*)(st + row * STP + ch * 16);
        *(u32x4*)(ob + (size_t)row * DM + ch * 8) = v;
    }
#undef DU_TID
#undef DU_PTRS
}

__device__ __forceinline__ void win_unit(LAS char* lds, int b, int kvh, int n, int hp, const bf16_t* proj, bf16_t* aout, const float* sink) {
    int tid_l = threadIdx.x; asm volatile("" : "+v"(tid_l)); const int tid = tid_l, lane = tid & 63, r32 = lane & 31, hi = lane >> 5, wid = __builtin_amdgcn_readfirstlane(tid >> 6);
    const size_t tok0 = (size_t)b * SEQ;
    const int a = kvh * 4 + 2 * hp + (wid >> 2);
    const int qrow = n * 128 + (wid & 3) * 32 + r32;
    const int t0 = (2 * n - 2 < 0) ? 0 : 2 * n - 2, t1 = (2 * n + 4 > SEQ / 64) ? SEQ / 64 : 2 * n + 4;
    f32x16 o[2]; float l;
    const float sink2 = sink[a] * LOG2E;
    flash_fast<64, true>(lds, proj + (tok0 + qrow) * NPROJ + a * 64, proj + tok0 * NPROJ + 512 + kvh * 64, proj + tok0 * NPROJ + 640 + kvh * 64,
                         t0, t1, qrow, __builtin_amdgcn_exp2f(sink2), o, l);
    if (wg_any(lds, pass_bad<2>(o, l)))
        flash_robust<64, true>(lds, proj + (tok0 + qrow) * NPROJ + a * 64, proj + tok0 * NPROJ + 512 + kvh * 64, proj + tok0 * NPROJ + 640 + kvh * 64,
                               t0, t1, qrow, sink2, 1.0f, false, o, l);
    __syncthreads();
    const float inv = 1.0f / l;
    LAS char* st = lds + OFF_ST + wid * ST_W;
#pragma unroll
    for (int blk = 0; blk < 2; ++blk)
#pragma unroll
        for (int g = 0; g < 4; ++g) {
            const int dv = 32 * blk + 8 * g + 4 * hi;
            u32x2 pw; pw.x = cvtpk(o[blk][4 * g] * inv, o[blk][4 * g + 1] * inv); pw.y = cvtpk(o[blk][4 * g + 2] * inv, o[blk][4 * g + 3] * inv);
            *(LAS u32x2*)(st + r32 * STP + dv * 2) = pw;
        }
    bf16_t* ob = aout + (tok0 + n * 128 + (wid & 3) * 32) * DM + a * 64;
#pragma unroll
    for (int i = 0; i < 4; ++i) {
        const int idx = i * 64 + lane, row = idx >> 3, ch = idx & 7;
        const u32x4 v = *(LAS const u32x4*)(st + row * STP + ch * 16);
        *(u32x4*)(ob + (size_t)row * DM + ch * 8) = v;
    }
}
constexpr int VPW = 192, VBW = 64 * VPW, RV = 6 * KBUF;
constexpr int RES_LDS = RV + 6 * VBW;
__device__ __forceinline__ void win_pass_fast(LAS char* lds, const bf16_t* Qrow, int nt, int t0, int qpos, float l_init, f32x16 (&o)[2], float& l_out) {
    int tid_l = threadIdx.x; asm volatile("" : "+v"(tid_l)); const int lane = tid_l & 63, r32 = lane & 31, hi = lane >> 5;
    bf16x8 qf[4];
#pragma unroll
    for (int d0 = 0; d0 < 4; ++d0) qf[d0] = *(const bf16x8*)(Qrow + d0 * 16 + hi * 8);
    const int kaddr = r32 * KP + hi * 16;
    const int vaddr = RV + (4 * hi + ((lane & 15) >> 2)) * VPW + (16 * ((lane >> 4) & 1) + 4 * (lane & 3)) * 2;
    const f32x16 zero16 = {0.f, 0.f, 0.f, 0.f, 0.f, 0.f, 0.f, 0.f, 0.f, 0.f, 0.f, 0.f, 0.f, 0.f, 0.f, 0.f};
    f32x16 sc0, sc1, sd0, sd1;
#pragma unroll
    for (int d0 = 0; d0 < 4; ++d0) {
        const bf16x8 k0_ = *(LAS const bf16x8*)(lds + kaddr + d0 * 32), k1_ = *(LAS const bf16x8*)(lds + kaddr + d0 * 32 + 32 * KP);
        if (d0 == 0) { sc0 = __builtin_amdgcn_mfma_f32_32x32x16_bf16(k0_, qf[0], zero16, 0, 0, 0); sc1 = __builtin_amdgcn_mfma_f32_32x32x16_bf16(k1_, qf[0], zero16, 0, 0, 0); }
        else { sc0 = __builtin_amdgcn_mfma_f32_32x32x16_bf16(k0_, qf[d0], sc0, 0, 0, 0); sc1 = __builtin_amdgcn_mfma_f32_32x32x16_bf16(k1_, qf[d0], sc1, 0, 0, 0); }
    }
    o[0] = zero16; o[1] = zero16;
    u32x4 pp[4] = {{0u, 0u, 0u, 0u}, {0u, 0u, 0u, 0u}, {0u, 0u, 0u, 0u}, {0u, 0u, 0u, 0u}};
    float lsum = (hi == 0) ? l_init : 0.f;
    int ks = KBUF, vp_ = 0, vc_ = 0;
    s16x4 vfr[8]; bf16x8 kf[4];
#pragma unroll
    for (int j = 0; j < 8; ++j) vfr[j] = vtr(lds + vaddr + (j >> 1) * 16 * VPW + (j & 1) * 8 * VPW);
#define WR_SV(S0, S1, i) ((i) < 16 ? S0[(i) & 15] : S1[(i) & 15])
#define WR_VF(s) ((bf16x8){vfr[(2 * (s)) & 7][0], vfr[(2 * (s)) & 7][1], vfr[(2 * (s)) & 7][2], vfr[(2 * (s)) & 7][3], vfr[(2 * (s) + 1) & 7][0], vfr[(2 * (s) + 1) & 7][1], vfr[(2 * (s) + 1) & 7][2], vfr[(2 * (s) + 1) & 7][3]})
#define WR_STEP(SC0, SC1, SN0, SN1, T) do { \
        { const int kb_ = 64 * (T) + 4 * hi - qpos + 128; \
          _Pragma("unroll") for (int r = 0; r < 16; ++r) { const int d_ = kb_ + (r & 3) + 8 * (r >> 2); \
              if ((unsigned)d_ > 256u) SC0[r] = -1e30f; if ((unsigned)(d_ + 32) > 256u) SC1[r] = -1e30f; } } \
        __builtin_amdgcn_sched_barrier(0); \
        _Pragma("unroll") for (int s_ = 0; s_ < 8; ++s_) { \
            const int blk = s_ >> 2, c = s_ & 3; \
            o[blk] = __builtin_amdgcn_mfma_f32_32x32x16_bf16(WR_VF(s_), __builtin_bit_cast(bf16x8, pp[c]), o[blk], 0, 0, 0); \
            if (s_ < 4) { vfr[(2 * s_) & 7] = vtr(lds + vp_ + vaddr + c * 16 * VPW + 64); vfr[(2 * s_ + 1) & 7] = vtr(lds + vp_ + vaddr + c * 16 * VPW + 8 * VPW + 64); } \
            else { const int j_ = s_ - 4; kf[j_] = *(LAS const bf16x8*)(lds + ks + kaddr + (j_ >> 1) * 32 + (j_ & 1) * 32 * KP); } \
            _Pragma("unroll") for (int e = 0; e < 4; ++e) { const int i_ = s_ * 4 + e; if (i_ < 16) SC0[i_ & 15] = __builtin_amdgcn_exp2f(SC0[i_ & 15]); else SC1[i_ & 15] = __builtin_amdgcn_exp2f(SC1[i_ & 15]); } \
            if (s_ > 0) { _Pragma("unroll") for (int e = 0; e < 4; ++e) lsum += WR_SV(SC0, SC1, (s_ - 1) * 4 + e); } \
            __builtin_amdgcn_sched_barrier(0); } \
        _Pragma("unroll") for (int j = 0; j < 8; ++j) { \
            const int d0 = j >> 1; \
            if ((j & 1) == 0) { if (d0 == 0) SN0 = __builtin_amdgcn_mfma_f32_32x32x16_bf16(kf[j & 3], qf[0], zero16, 0, 0, 0); else SN0 = __builtin_amdgcn_mfma_f32_32x32x16_bf16(kf[j & 3], qf[d0], SN0, 0, 0, 0); } \
            else { if (d0 == 0) SN1 = __builtin_amdgcn_mfma_f32_32x32x16_bf16(kf[j & 3], qf[0], zero16, 0, 0, 0); else SN1 = __builtin_amdgcn_mfma_f32_32x32x16_bf16(kf[j & 3], qf[d0], SN1, 0, 0, 0); } \
            if (j < 4) { const int j_ = j + 4; kf[j & 3] = *(LAS const bf16x8*)(lds + ks + kaddr + (j_ >> 1) * 32 + (j_ & 1) * 32 * KP); } \
            else { const int n_ = j - 4; vfr[2 * n_] = vtr(lds + vc_ + vaddr + n_ * 16 * VPW); vfr[2 * n_ + 1] = vtr(lds + vc_ + vaddr + n_ * 16 * VPW + 8 * VPW); } \
            if (j == 0) { _Pragma("unroll") for (int e = 0; e < 4; ++e) lsum += WR_SV(SC0, SC1, 28 + e); } \
            _Pragma("unroll") for (int w_ = 2 * j; w_ < 2 * j + 2; ++w_) { const int c = w_ >> 2, e = w_ & 3; \
                pp[c][e] = (c < 2) ? cvtpk(SC0[(8 * c + 2 * e) & 15], SC0[(8 * c + 2 * e + 1) & 15]) : cvtpk(SC1[(8 * (c - 2) + 2 * e) & 15], SC1[(8 * (c - 2) + 2 * e + 1) & 15]); } \
            __builtin_amdgcn_sched_barrier(0); } \
        ks += KBUF; vp_ = vc_; vc_ += VBW; } while (0)
    for (int i = 0; i < nt; i += 2) {
        WR_STEP(sc0, sc1, sd0, sd1, t0 + i);
        if (i == 0) vp_ = 0;
        WR_STEP(sd0, sd1, sc0, sc1, t0 + i + 1);
    }
#pragma unroll
    for (int blk = 0; blk < 2; ++blk)
#pragma unroll
        for (int c = 0; c < 4; ++c) {
            const s16x4 lo = vtr(lds + vp_ + vaddr + c * 16 * VPW + blk * 64), hh = vtr(lds + vp_ + vaddr + c * 16 * VPW + 8 * VPW + blk * 64);
            const bf16x8 vf = (bf16x8){lo[0], lo[1], lo[2], lo[3], hh[0], hh[1], hh[2], hh[3]};
            o[blk] = __builtin_amdgcn_mfma_f32_32x32x16_bf16(vf, __builtin_bit_cast(bf16x8, pp[c]), o[blk], 0, 0, 0);
        }
    l_out = halfswap_add(lsum);
#undef WR_SV
#undef WR_VF
#undef WR_STEP
}
__device__ __forceinline__ void win_pass_robust(LAS char* lds, const bf16_t* Qrow, int nt, int t0, int qpos, float sink2, f32x16 (&o)[2], float& l_out) {
    int tid_l = threadIdx.x; asm volatile("" : "+v"(tid_l)); const int lane = tid_l & 63, r32 = lane & 31, hi = lane >> 5;
    bf16x8 qf[4];
#pragma unroll
    for (int d0 = 0; d0 < 4; ++d0) qf[d0] = *(const bf16x8*)(Qrow + d0 * 16 + hi * 8);
    const int kaddr = r32 * KP + hi * 16;
    const int vaddr = RV + (4 * hi + ((lane & 15) >> 2)) * VPW + (16 * ((lane >> 4) & 1) + 4 * (lane & 3)) * 2;
    float mref = sink2, lsum = (hi == 0) ? 1.0f : 0.f;
#pragma unroll
    for (int blk = 0; blk < 2; ++blk)
#pragma unroll
        for (int r = 0; r < 16; ++r) o[blk][r] = 0.f;
    for (int i = 0; i < nt; ++i) {
        LAS const char* Kc = lds + i * KBUF + kaddr;
        LAS const char* Vc = lds + i * VBW + vaddr;
        f32x16 p0, p1;
#pragma unroll
        for (int r = 0; r < 16; ++r) { p0[r] = -mref; p1[r] = -mref; }
#pragma unroll
        for (int d0 = 0; d0 < 4; ++d0) {
            const bf16x8 k0 = *(LAS const bf16x8*)(Kc + d0 * 32), k1 = *(LAS const bf16x8*)(Kc + d0 * 32 + 32 * KP);
            p0 = __builtin_amdgcn_mfma_f32_32x32x16_bf16(k0, qf[d0], p0, 0, 0, 0);
            p1 = __builtin_amdgcn_mfma_f32_32x32x16_bf16(k1, qf[d0], p1, 0, 0, 0);
        }
        { const int kb = 64 * (t0 + i) + 4 * hi - qpos + 128;
#pragma unroll
          for (int r = 0; r < 16; ++r) { const int d = kb + (r & 3) + 8 * (r >> 2); if ((unsigned)d > 256u) p0[r] = -1e30f; if ((unsigned)(d + 32) > 256u) p1[r] = -1e30f; } }
        float rm = fmaxf(p0[0], p1[0]);
#pragma unroll
        for (int r = 1; r < 16; ++r) rm = fmaxf(rm, fmaxf(p0[r], p1[r]));
        rm = fmaxf(rm, __shfl_xor(rm, 32));
        if (__any(rm > 8.0f)) {
            const float dl = fmaxf(rm, 0.f), al = __builtin_amdgcn_exp2f(-dl);
            mref += dl; lsum *= al;
#pragma unroll
            for (int r = 0; r < 16; ++r) { p0[r] -= dl; p1[r] -= dl; o[0][r] *= al; o[1][r] *= al; }
        }
        float s0 = 0.f;
#pragma unroll
        for (int r = 0; r < 16; ++r) { p0[r] = __builtin_amdgcn_exp2f(p0[r]); p1[r] = __builtin_amdgcn_exp2f(p1[r]); s0 += p0[r] + p1[r]; }
        lsum += s0;
        u32x4 pk[4];
#pragma unroll
        for (int c = 0; c < 2; ++c) {
            pk[c].x = cvtpk(p0[8 * c + 0], p0[8 * c + 1]); pk[c].y = cvtpk(p0[8 * c + 2], p0[8 * c + 3]); pk[c].z = cvtpk(p0[8 * c + 4], p0[8 * c + 5]); pk[c].w = cvtpk(p0[8 * c + 6], p0[8 * c + 7]);
            pk[2 + c].x = cvtpk(p1[8 * c + 0], p1[8 * c + 1]); pk[2 + c].y = cvtpk(p1[8 * c + 2], p1[8 * c + 3]); pk[2 + c].z = cvtpk(p1[8 * c + 4], p1[8 * c + 5]); pk[2 + c].w = cvtpk(p1[8 * c + 6], p1[8 * c + 7]);
        }
#pragma unroll
        for (int blk = 0; blk < 2; ++blk)
#pragma unroll
            for (int c = 0; c < 4; ++c) {
                const s16x4 lo = vtr(Vc + c * 16 * VPW + blk * 64), hh = vtr(Vc + c * 16 * VPW + 8 * VPW + blk * 64);
                const bf16x8 vf = (bf16x8){lo[0], lo[1], lo[2], lo[3], hh[0], hh[1], hh[2], hh[3]};
                o[blk] = __builtin_amdgcn_mfma_f32_32x32x16_bf16(vf, __builtin_bit_cast(bf16x8, pk[c]), o[blk], 0, 0, 0);
            }
    }
    l_out = lsum + __shfl_xor(lsum, 32);
}
__device__ __forceinline__ void win_unit4(LAS char* lds, int b, int kvh, int n, const bf16_t* proj, bf16_t* aout, const float* sink) {
    const size_t tok0 = (size_t)b * SEQ;
    const int t0 = (2 * n - 2 < 0) ? 0 : 2 * n - 2, t1 = (2 * n + 4 > SEQ / 64) ? SEQ / 64 : 2 * n + 4, nt = t1 - t0;
    {
        int tid_l = threadIdx.x; asm volatile("" : "+v"(tid_l)); const int tid = tid_l, krow = tid >> 3, kch = tid & 7;
        const bf16_t* kg = proj + (tok0 + (size_t)t0 * 64 + krow) * NPROJ + 512 + kvh * 64 + kch * 8;
        u32x4 kr[6], vr[6];
#pragma unroll
        for (int i = 0; i < 6; ++i) if (i < nt) { kr[i] = *(const u32x4*)(kg + (size_t)i * 64 * NPROJ); vr[i] = *(const u32x4*)(kg + (size_t)i * 64 * NPROJ + 128); }
        __syncthreads();
#pragma unroll
        for (int i = 0; i < 6; ++i) if (i < nt) { *(LAS u32x4*)(lds + i * KBUF + krow * KP + kch * 16) = kr[i]; *(LAS u32x4*)(lds + RV + i * VBW + krow * VPW + kch * 16) = vr[i]; }
        __syncthreads();
    }
#pragma unroll 1
    for (int hp = 0; hp < 2; ++hp) {
        int tid_l = threadIdx.x; asm volatile("" : "+v"(tid_l)); const int tid = tid_l, lane = tid & 63, r32 = lane & 31, hi = lane >> 5, wid = __builtin_amdgcn_readfirstlane(tid >> 6);
        const int a = kvh * 4 + 2 * hp + (wid >> 2);
        const int qrow = n * 128 + (wid & 3) * 32 + r32;
        const float sink2 = sink[a] * LOG2E;
        const bf16_t* qp = proj + (tok0 + qrow) * NPROJ + a * 64;
        f32x16 o[2]; float l;
        win_pass_fast(lds, qp, nt, t0, qrow, __builtin_amdgcn_exp2f(sink2), o, l);
        if (__any(pass_bad<2>(o, l))) win_pass_robust(lds, qp, nt, t0, qrow, sink2, o, l);
        const float inv = 1.0f / l;
        bf16_t* ob = aout + (tok0 + qrow) * DM + a * 64 + 4 * hi;
#pragma unroll
        for (int blk = 0; blk < 2; ++blk)
#pragma unroll
            for (int g = 0; g < 4; ++g) {
                u32x2 pw; pw.x = cvtpk(o[blk][4 * g] * inv, o[blk][4 * g + 1] * inv); pw.y = cvtpk(o[blk][4 * g + 2] * inv, o[blk][4 * g + 3] * inv);
                *(u32x2*)(ob + 32 * blk + 8 * g) = pw;
            }
    }
}
}

constexpr size_t MiB = 1u << 20;
constexpr size_t WS_MOD = 0;
constexpr size_t WS_COS = 1 * MiB, WS_SIN = 1 * MiB + 512 * 1024;
constexpr size_t WS_ST1 = 3 * MiB;
constexpr size_t WS_WIN = 4 * MiB, WS_WAB = 13 * MiB, WS_WO = 15 * MiB, WS_WGU = 17 * MiB, WS_WDN = 28 * MiB;
constexpr size_t WS_OSCR = 34 * MiB;
constexpr size_t WS_MRG = 66 * MiB;
constexpr size_t WS_PROJ = 226 * MiB;
constexpr size_t WS_END = 906 * MiB;
constexpr int LDS_BYTES = 147456;
constexpr int NWAVES = 8;
typedef float f32x4 __attribute__((ext_vector_type(4)));
typedef float f32x2g __attribute__((ext_vector_type(2)));
typedef unsigned u32x4g __attribute__((ext_vector_type(4)));
typedef unsigned short bf16;

#ifndef REPEAT_MASK
#define REPEAT_MASK 0
#endif
#ifndef PHASE_MASK
#define PHASE_MASK 0x3ff
#endif
struct Params { const float* in[22]; float* out; unsigned char* ws; };
enum { I_XP = 0, I_XS, I_CP, I_CS, I_WADA, I_BADA, I_WIN, I_SINK, I_LQ1, I_LK1, I_LQ2, I_LK2, I_SUBW, I_WA, I_WB, I_WO, I_LN1G, I_LN1B, I_WGU, I_WDN, I_LN2G, I_LN2B };

__device__ const float ROPE_INV[32] = {1.000000000e+00f, 7.498942018e-01f, 5.623413324e-01f, 4.216965139e-01f, 3.162277639e-01f, 2.371373922e-01f, 1.778279394e-01f, 1.333521456e-01f,
    1.000000015e-01f, 7.498941571e-02f, 5.623412877e-02f, 4.216964915e-02f, 3.162277862e-02f, 2.371373586e-02f, 1.778279431e-02f, 1.333521493e-02f,
    9.999999776e-03f, 7.498942316e-03f, 5.623413250e-03f, 4.216964822e-03f, 3.162277862e-03f, 2.371373819e-03f, 1.778279431e-03f, 1.333521446e-03f,
    1.000000047e-03f, 7.498941850e-04f, 5.623413017e-04f, 4.216965463e-04f, 3.162277862e-04f, 2.371373848e-04f, 1.778279402e-04f, 1.333521504e-04f};

__device__ __forceinline__ unsigned f2bf(float f) { unsigned u = __builtin_bit_cast(unsigned, f); return (u + 0x7fffu + ((u >> 16) & 1u)) >> 16; }
__device__ __forceinline__ unsigned pk2(float lo, float hi) { return f2bf(lo) | (f2bf(hi) << 16); }
__device__ __forceinline__ float wave_sum(float v) {
#pragma unroll
    for (int o = 1; o < 64; o <<= 1) v += __shfl_xor(v, o);
    return v;
}
__device__ __forceinline__ int colmap(int mode, int L) {
    if (mode == 1) {
        if (L < 640 || (L >= 768 && L < 1792)) { const int j = L & 63, base = L - j; return base + (j < 32 ? 2 * j : 2 * (j - 32) + 1); }
        return L;
    }
    if (mode == 2) {
        if (L < DFF) return (L >> 7) * 256 + (L & 127);
        const int i = L - DFF; return (i >> 7) * 256 + 128 + (i & 127);
    }
    return L;
}
__device__ __forceinline__ void tr_item(const float* W, int N, bf16* WT, int ldt, int koff, int item, int mode, LAS float* scr, int lane) {
    const int nblk = N / 32, kb = item / nblk, nb = item % nblk, k0 = 64 * kb, n0 = 32 * nb;
#pragma unroll 8
    for (int i = 0; i < 32; ++i) { const int kk = 2 * i + (lane >> 5); scr[kk * 33 + (lane & 31)] = W[(size_t)(k0 + kk) * N + n0 + (lane & 31)]; }
    asm volatile("s_waitcnt lgkmcnt(0)" ::: "memory");
    const int c = lane & 7;
#pragma unroll
    for (int j = 0; j < 4; ++j) {
        const int n = (lane >> 3) + 8 * j; const LAS float* s = scr + (8 * c) * 33 + n;
        u32x4g o; o.x = pk2(s[0 * 33], s[1 * 33]); o.y = pk2(s[2 * 33], s[3 * 33]); o.z = pk2(s[4 * 33], s[5 * 33]); o.w = pk2(s[6 * 33], s[7 * 33]);
        *(u32x4g*)(WT + (size_t)colmap(mode, n0 + n) * ldt + koff + k0 + 8 * c) = o;
    }
    asm volatile("s_waitcnt lgkmcnt(0)" ::: "memory");
}

__device__ __forceinline__ void sincos_d(double a, float& sn, float& cs) {
    const double n = __builtin_rint(a * 0.63661977236758134308);
    double r = __builtin_fma(-n, 1.57079632679489655800, a);
    r = __builtin_fma(-n, 6.12323399573676603587e-17, r);
    const double r2 = r * r;
    double s = 1.0 / 6227020800.0;
    s = s * r2 - 1.0 / 39916800.0; s = s * r2 + 1.0 / 362880.0; s = s * r2 - 1.0 / 5040.0; s = s * r2 + 1.0 / 120.0; s = s * r2 - 1.0 / 6.0;
    s = r + r * r2 * s;
    double c = -1.0 / 87178291200.0;
    c = c * r2 + 1.0 / 479001600.0; c = c * r2 - 1.0 / 3628800.0; c = c * r2 + 1.0 / 40320.0; c = c * r2 - 1.0 / 720.0; c = c * r2 + 1.0 / 24.0; c = c * r2 - 0.5;
    c = 1.0 + r2 * c;
    const int q = ((int)n) & 3;
    const double ss = (q == 0) ? s : (q == 1) ? c : (q == 2) ? -s : -c;
    const double cc = (q == 0) ? c : (q == 1) ? -s : (q == 2) ? -c : s;
    sn = (float)ss; cs = (float)cc;
}

#define XB_TMO      128
#define XB_XCNT(j)  (256  + 64 * (j))
#define XB_XSUB(j)  (1280 + 64 * (j))
#define XB_XGEN(j)  (2304 + 64 * (j))
#define XB_TOP      3328
#define XB_TOPGEN   3392
#define XCD_BAR_WORDS 3456
#define XB_SPIN_CAP (1u << 18)

__device__ __forceinline__ unsigned xb_ld(unsigned* p)              { return __hip_atomic_load(p, __ATOMIC_RELAXED, __HIP_MEMORY_SCOPE_AGENT); }
__device__ __forceinline__ unsigned xb_add(unsigned* p, unsigned v) { return __hip_atomic_fetch_add(p, v, __ATOMIC_RELAXED, __HIP_MEMORY_SCOPE_AGENT); }
__device__ __forceinline__ unsigned xb_xcc_id() { return (unsigned)__builtin_amdgcn_s_getreg((3 << 11) | 20) & 0xFu; }
#define XB_SPIN(cond, bar) do { unsigned _sp = 0; while (cond) { __builtin_amdgcn_s_sleep(1); \
    if ((++_sp & 255u) == 0u) { if (xb_ld(&(bar)[XB_TMO])) break; if (_sp > XB_SPIN_CAP) { atomicAdd(&(bar)[XB_TMO], 1u); break; } } } } while (0)

struct XcdBarrier {
    unsigned* bar; unsigned x;
    volatile LAS unsigned* st;
};

__device__ __forceinline__ XcdBarrier xcd_barrier_post(unsigned* bar, volatile LAS unsigned* st) {
    XcdBarrier b; b.bar = bar; b.x = xb_xcc_id(); b.st = st;
    if (threadIdx.x == 0) (void)xb_add(&bar[XB_XCNT(b.x)], 1u);
    return b;
}
__device__ __forceinline__ void xcd_barrier_complete(unsigned* bar, unsigned x, unsigned& nloc, unsigned& nx) {
    const unsigned G = gridDim.x * gridDim.y * gridDim.z;
    unsigned sum, cnt, mine, sp = 0u;
    for (;;) {
        sum = 0u; cnt = 0u; mine = 0u;
#pragma unroll
        for (unsigned j = 0; j < 16; ++j) { const unsigned c = xb_ld(&bar[XB_XCNT(j)]); sum += c; cnt += (c > 0u) ? 1u : 0u; mine = (j == x) ? c : mine; }
        if (sum == G) break;
        __builtin_amdgcn_s_sleep(1);
        if ((++sp & 255u) == 0u) { if (xb_ld(&bar[XB_TMO])) break; if (sp > XB_SPIN_CAP) { atomicAdd(&bar[XB_TMO], 1u); break; } }
    }
    nloc = mine > 0u ? mine : 1u; nx = cnt > 0u ? cnt : 1u;
}

__device__ __forceinline__ void xcd_barrier(const XcdBarrier& b) {
    asm volatile("s_waitcnt vmcnt(0)" ::: "memory");
    __syncthreads();
    if (threadIdx.x == 0) {
        unsigned* bar = b.bar;
        __builtin_amdgcn_s_waitcnt(0);
        unsigned nloc = b.st[0], nx = b.st[1];
        if (nloc == 0u) { xcd_barrier_complete(bar, b.x, nloc, nx); b.st[0] = nloc; b.st[1] = nx; }
        const unsigned old = xb_add(&bar[XB_XSUB(b.x)], 1u);
        const unsigned gen = old / nloc;
        if (old + 1u == (gen + 1u) * nloc) {
            __builtin_amdgcn_fence(__ATOMIC_RELEASE, "agent");
            asm volatile("s_waitcnt vmcnt(0)" ::: "memory");
            const unsigned og = xb_add(&bar[XB_TOP], 1u);
            const unsigned tg = og / nx;
            if (og + 1u == (tg + 1u) * nx) xb_add(&bar[XB_TOPGEN], 1u);
            else XB_SPIN(xb_ld(&bar[XB_TOPGEN]) == tg, bar);
            __builtin_amdgcn_fence(__ATOMIC_ACQUIRE, "agent");
            xb_add(&bar[XB_XGEN(b.x)], 1u);
            asm volatile("s_waitcnt vmcnt(0)" ::: "memory");
        } else {
            XB_SPIN(xb_ld(&bar[XB_XGEN(b.x)]) == gen, bar);
            __builtin_amdgcn_fence(__ATOMIC_ACQUIRE, "agent");
            asm volatile("s_waitcnt vmcnt(0)" ::: "memory");
        }
    }
    __syncthreads();
}

constexpr size_t WS_BAR = 491520;
constexpr size_t WS_ZERO_BYTES = WS_BAR + 16384;
static_assert(XCD_BAR_WORDS * 4 <= 16384 && WS_ZERO_BYTES <= WS_COS && (size_t)NBATCH * MODN * 4 <= WS_BAR, "control words");
constexpr int XB_LDS_OFF = LDS_BYTES - 64;
__global__ void __launch_bounds__(NWAVES * 64, 2) mega_fwd(Params P) {
    extern __shared__ __attribute__((aligned(16))) unsigned char lds_raw[];
    cg::grid_group grid = cg::this_grid();
    LAS unsigned char* lds = (LAS unsigned char*)lds_raw;
    volatile LAS unsigned* xst = (volatile LAS unsigned*)(lds + XB_LDS_OFF);
    if (threadIdx.x < 2) xst[threadIdx.x] = 0u;
    __syncthreads();
    const XcdBarrier xbar = xcd_barrier_post((unsigned*)(P.ws + WS_BAR), xst);
#define PHASE_VARS \
    int tid = threadIdx.x; asm volatile("" : "+v"(tid)); \
    const int lane = tid & 63, wid = __builtin_amdgcn_readfirstlane(tid >> 6); \
    const int G = gridDim.x, bid = blockIdx.x; \
    const int vcu = (G % 8 == 0) ? (bid % 8) * (G / 8) + bid / 8 : bid; \
    unsigned char* ws = P.ws; \
    float* modb = (float*)(ws + WS_MOD); float* cosT = (float*)(ws + WS_COS); float* sinT = (float*)(ws + WS_SIN); \
    f32x2g* st1 = (f32x2g*)(ws + WS_ST1); \
    bf16* Win_t = (bf16*)(ws + WS_WIN); bf16* Wab_t = (bf16*)(ws + WS_WAB); bf16* Wo_t = (bf16*)(ws + WS_WO); bf16* Wgu_t = (bf16*)(ws + WS_WGU); bf16* Wdn_t = (bf16*)(ws + WS_WDN); \
    bf16* mrg = (bf16*)(ws + WS_MRG); bf16* proj = (bf16*)(ws + WS_PROJ); bf16* hid = (bf16*)(ws + WS_PROJ); \
    bf16* hbuf = (bf16*)P.out; bf16* aout = (bf16*)((unsigned char*)P.out + 160 * MiB); float* Y = P.out; \
    h16_t* Y16 = (h16_t*)P.out; h16_t* Z16 = (h16_t*)(ws + WS_MRG); (void)Y16; (void)Z16;     \
    const float* bada = P.in[I_BADA]; \
    const int gw = bid * NWAVES + wid, NGW = G * NWAVES; \
    (void)lane; (void)vcu; (void)modb; (void)cosT; (void)sinT; (void)st1; (void)Win_t; (void)Wab_t; (void)Wo_t; (void)Wgu_t; (void)Wdn_t; (void)mrg; (void)proj; (void)hid; (void)hbuf; (void)aout; (void)Y; (void)bada; (void)gw; (void)NGW;

    if constexpr ((PHASE_MASK >> 0) & 1) {
        PHASE_VARS
        for (int it = gw; it < 96 * 16; it += NGW) {
            const int cb = it % 96, ks = it / 96, n = cb * 64 + lane, k0 = ks * 64;
            float sv[NBATCH], acc[NBATCH];
#pragma unroll
            for (int b = 0; b < NBATCH; ++b) {
                const float c = (b < 16) ? P.in[I_CP][b * DM + k0 + lane] : P.in[I_CS][(b - 16) * DM + k0 + lane];
                sv[b] = c * sigmoidf_fast(c); acc[b] = 0.f;
            }
            const float* wp = P.in[I_WADA] + (size_t)k0 * MODN + n;
#pragma unroll 16
            for (int kk = 0; kk < 64; ++kk) {
                const float w = wp[(size_t)kk * MODN];
#pragma unroll
                for (int b = 0; b < NBATCH; ++b) acc[b] += __builtin_bit_cast(float, __builtin_amdgcn_readlane(__builtin_bit_cast(int, sv[b]), kk)) * w;
            }
#pragma unroll
            for (int b = 0; b < NBATCH; ++b) atomicAdd(modb + b * MODN + n, acc[b]);
        }
    }
    if constexpr ((PHASE_MASK >> 0) & 1) {
        PHASE_VARS
        for (int e = bid * (NWAVES * 64) + tid; e < SEQ * 32; e += G * NWAVES * 64) {
            const int pos = e >> 5, i = e & 31;
            const float ang = (float)pos * ROPE_INV[i];
            float sn, cs; sincos_d((double)ang, sn, cs);
            cosT[e] = cs; sinT[e] = sn;
        }
        LAS float* scr = (LAS float*)(lds + wid * 8704);
        constexpr int I_IN = 16 * (NPROJ / 32), I_A = 8 * 32, I_O = 16 * 32, I_GU = 16 * (2 * DFF / 32), I_DN = (DFF / 64) * 32;
        constexpr int NITEMS = I_IN + 2 * I_A + I_O + I_GU + I_DN;
        (void)NITEMS;
        for (int it = NGW - 1 - gw; it < I_IN; it += NGW) tr_item(P.in[I_WIN], NPROJ, Win_t, DM, 0, it, 1, scr, lane);
    }
    if (P.ws == nullptr) grid.sync();
    xcd_barrier(xbar);

    for (int rep_ = 0; rep_ < (int)((REPEAT_MASK >> 1) & 1) + 1; ++rep_) {
        if (rep_) grid.sync();
        PHASE_VARS
        constexpr int RPW = 40;
        for (int ch = gw; ch < T_TOK / RPW; ch += NGW) {
            int curb = -1; f32x4 A[4], B[4];
            f32x4 xv[4], xn[4], xm[4];
#define P1_XROW(r_) (((r_) < 65536) ? P.in[I_XP] + (size_t)(r_) * DM : P.in[I_XS] + (size_t)((r_) - 65536) * DM)
            { const float* xr = P1_XROW(ch * RPW);
#pragma unroll
              for (int j = 0; j < 4; ++j) xv[j] = __builtin_nontemporal_load((const f32x4*)(xr + 4 * lane + 256 * j));
              const float* xr1 = P1_XROW(ch * RPW + 1);
#pragma unroll
              for (int j = 0; j < 4; ++j) xn[j] = __builtin_nontemporal_load((const f32x4*)(xr1 + 4 * lane + 256 * j)); }
            for (int r = ch * RPW; r < ch * RPW + RPW; ++r) {
                if (r + 2 < ch * RPW + RPW) { const float* xr = P1_XROW(r + 2);
#pragma unroll
                    for (int j = 0; j < 4; ++j) xm[j] = __builtin_nontemporal_load((const f32x4*)(xr + 4 * lane + 256 * j)); }
                const int b = r >> 12;
                if (b != curb) { curb = b;
#pragma unroll
                    for (int j = 0; j < 4; ++j) { const int c = 4 * lane + 256 * j;
                        A[j] = *(const f32x4*)(modb + b * MODN + DM + c) + *(const f32x4*)(bada + DM + c) + 1.0f;
                        B[j] = *(const f32x4*)(modb + b * MODN + c) + *(const f32x4*)(bada + c); } }
#pragma unroll
                for (int j = 0; j < 4; ++j) { const int c = 4 * lane + 256 * j;
                    const f32x4 v = xv[j] * A[j] + B[j];
                    u32x2 w; w.x = pk2(v[0], v[1]); w.y = pk2(v[2], v[3]);
                    *(u32x2*)(hbuf + (size_t)r * DM + c) = w; }
#pragma unroll
                for (int j = 0; j < 4; ++j) { xv[j] = xn[j]; xn[j] = xm[j]; }
            }
#undef P1_XROW
        }
    }
    xcd_barrier(xbar);

    for (int rep_ = 0; rep_ < (int)((REPEAT_MASK >> 2) & 1) + 1; ++rep_) {
        if (rep_) grid.sync();
        PHASE_VARS
        pg8::Gemm g{hbuf, Win_t, T_TOK, NPROJ, DM}; pg8::StaticOrder S; S.init(T_TOK, NPROJ, G, bid);
        pg8::EpiProj E{proj, cosT, sinT};
        pg8::gemm_phase<pg8::EpiProj, pg8::StaticOrder, true, true>(lds, g, S, E);
        if (rep_ == 0) {
            constexpr int I_A = 8 * 32, I_O = 16 * 32, I_GU = 16 * (2 * DFF / 32), I_DN = (DFF / 64) * 32, NREST = 2 * I_A + I_O + I_GU + I_DN;
            const int rem = ((T_TOK / 256) * (NPROJ / 256)) % G;
            const int nh = (rem == 0) ? G : G - rem, hb = (rem == 0) ? bid : bid - rem;
            if (hb >= 0) {
                LAS float* scr = (LAS float*)(lds + wid * 8704);
                for (int it = hb * NWAVES + wid; it < NREST; it += nh * NWAVES) {
                    int r = it;
                    if (r < I_A) { tr_item(P.in[I_WA], DM, Wab_t, DM, 0, r, 0, scr, lane); continue; } r -= I_A;
                    if (r < I_A) { tr_item(P.in[I_WB], DM, Wab_t, DM, 512, r, 0, scr, lane); continue; } r -= I_A;
                    if (r < I_O) { tr_item(P.in[I_WO], DM, Wo_t, DM, 0, r, 0, scr, lane); continue; } r -= I_O;
                    if (r < I_GU) { tr_item(P.in[I_WGU], 2 * DFF, Wgu_t, DM, 0, r, 2, scr, lane); continue; } r -= I_GU;
                    tr_item(P.in[I_WDN], DM, Wdn_t, DFF, 0, r, 0, scr, lane);
                }
            }
        }
    }
    xcd_barrier(xbar);

    for (int rep_ = 0; rep_ < (int)((REPEAT_MASK >> 3) & 1) + 1; ++rep_) {
        if (rep_) grid.sync();
        PHASE_VARS
        float lam;
        {
            const float a = P.in[I_LQ1][lane] * P.in[I_LK1][lane], b2 = P.in[I_LQ2][lane] * P.in[I_LK2][lane];
            lam = __expf(wave_sum(a)) - __expf(wave_sum(b2)) + 0.2f;
        }
        float* oscr = (float*)(ws + WS_OSCR) + (size_t)bid * 32768;
        for (int u = vcu; u < NBATCH * 4 * 16; u += G) {
            const int qb = u & 15, bh = u >> 4;
            att::diff_unit((LAS char*)lds, bh >> 2, bh & 3, qb, proj, aout, oscr, lam, P.in[I_SUBW]);
        }
        static_assert(att::RES_LDS <= XB_LDS_OFF, "resident window tiles fit under the barrier words");
        for (int u = vcu; u < NBATCH * 2 * 32; u += G) {
            const int n = u & 31, bk = u >> 5;
            att::win_unit4((LAS char*)lds, bk >> 1, bk & 1, n, proj, aout, P.in[I_SINK]);
        }
    }
    xcd_barrier(xbar);

    for (int rep_ = 0; rep_ < (int)((REPEAT_MASK >> 4) & 1) + 1; ++rep_) {
        if (rep_) grid.sync();
        PHASE_VARS
        pg8::Gemm g{aout, Wab_t, T_TOK, DM, DM}; pg8::StaticOrder S; S.init(T_TOK, DM, G, bid);
        pg8::EpiMerge E{proj, mrg};
        pg8::gemm_phase<pg8::EpiMerge, pg8::StaticOrder, true, true>(lds, g, S, E);
    }
    xcd_barrier(xbar);

    for (int rep_ = 0; rep_ < (int)((REPEAT_MASK >> 5) & 1) + 1; ++rep_) {
        if (rep_) grid.sync();
        PHASE_VARS
        pg8::Gemm g{mrg, Wo_t, T_TOK, DM, DM}; pg8::StaticOrder S; S.init(T_TOK, DM, G, bid);
        pg8::EpiWo E{P.in[I_XP], P.in[I_XS], modb, bada, Y16};
        pg8::gemm_phase<pg8::EpiWo, pg8::StaticOrder, true, true>(lds, g, S, E);
    }
    xcd_barrier(xbar);

    for (int rep_ = 0; rep_ < (int)((REPEAT_MASK >> 6) & 1) + 1; ++rep_) {
        if (rep_) grid.sync();
        PHASE_VARS
        constexpr int RPW = 40;
        f32x4 G1[4], B1[4];
#pragma unroll
        for (int j = 0; j < 4; ++j) { const int c = 4 * lane + 256 * j; G1[j] = *(const f32x4*)(P.in[I_LN1G] + c); B1[j] = *(const f32x4*)(P.in[I_LN1B] + c); }
        for (int ch = gw; ch < T_TOK / RPW; ch += NGW) {
            int curb = -1; f32x4 A[4], B[4]; h16x4 pa[4], pb[4];
            for (int r = ch * RPW; r < ch * RPW + RPW; ++r) {
                const int b = r >> 12;
                if (b != curb) { curb = b;
#pragma unroll
                    for (int j = 0; j < 4; ++j) { const int c = 4 * lane + 256 * j;
                        A[j] = *(const f32x4*)(modb + b * MODN + 4 * DM + c) + *(const f32x4*)(bada + 4 * DM + c) + 1.0f;
                        B[j] = *(const f32x4*)(modb + b * MODN + 3 * DM + c) + *(const f32x4*)(bada + 3 * DM + c); } }
#define P6_LD(dst, r_) do { _Pragma("unroll") for (int j = 0; j < 4; ++j) dst[j] = *(const h16x4*)(Y16 + (size_t)(r_) * DM + 4 * lane + 256 * j); } while (0)
                if (r == ch * RPW) { P6_LD(pa, r); P6_LD(pb, r + 1); }
                f32x4 v[4]; float s = 0.f;
#pragma unroll
                for (int j = 0; j < 4; ++j) { v[j] = __builtin_convertvector(pa[j], f32x4); pa[j] = pb[j]; s += (v[j][0] + v[j][1]) + (v[j][2] + v[j][3]); }
                if (r + 2 < ch * RPW + RPW) P6_LD(pb, r + 2);
#undef P6_LD
                const float mean = wave_sum(s) * (1.0f / DM); float q = 0.f;
#pragma unroll
                for (int j = 0; j < 4; ++j) { const f32x4 d = v[j] - mean; q += (d[0] * d[0] + d[1] * d[1]) + (d[2] * d[2] + d[3] * d[3]); }
                const float rstd = 1.0f / sqrtf(wave_sum(q) * (1.0f / DM) + LN_EPS);
                if (lane == 0) st1[r] = (f32x2g){mean, rstd};
#pragma unroll
                for (int j = 0; j < 4; ++j) { const int c = 4 * lane + 256 * j;
                    const f32x4 x1 = (v[j] - mean) * rstd * G1[j] + B1[j];
                    const f32x4 hv = x1 * A[j] + B[j];
                    u32x2 w; w.x = pk2(hv[0], hv[1]); w.y = pk2(hv[2], hv[3]);
                    *(u32x2*)(mrg + (size_t)r * DM + c) = w; }
            }
        }
    }
    xcd_barrier(xbar);

    for (int rep_ = 0; rep_ < (int)((REPEAT_MASK >> 7) & 1) + 1; ++rep_) {
        if (rep_) grid.sync();
        PHASE_VARS
        pg8::Gemm g{mrg, Wgu_t, T_TOK, 2 * DFF, DM}; pg8::StaticOrder S; S.init(T_TOK, 2 * DFF, G, bid);
        pg8::EpiGU E{hid};
        pg8::gemm_phase<pg8::EpiGU, pg8::StaticOrder, true, true>(lds, g, S, E);
    }
    xcd_barrier(xbar);

    if constexpr ((PHASE_MASK >> 8) & 1) {
        PHASE_VARS
        pg8::Gemm g{hid, Wdn_t, T_TOK, DM, DFF}; pg8::StaticOrder S; S.init(T_TOK, DM, G, bid);
        pg8::EpiDown E{Y16, Z16, (const pg8::f32x2*)st1, modb, bada, P.in[I_LN1G], P.in[I_LN1B]};
        pg8::gemm_phase<pg8::EpiDown, pg8::StaticOrder, true, true>(lds, g, S, E);
    }
    xcd_barrier(xbar);

    if constexpr ((PHASE_MASK >> 9) & 1) {
        PHASE_VARS
        f32x4 G2[4], B2[4];
#pragma unroll
        for (int j = 0; j < 4; ++j) { const int c = 4 * lane + 256 * j; G2[j] = *(const f32x4*)(P.in[I_LN2G] + c); B2[j] = *(const f32x4*)(P.in[I_LN2B] + c); }
        h16x4 pa[4], pb[4];
#define P9_LD(dst, r_) do { _Pragma("unroll") for (int j = 0; j < 4; ++j) dst[j] = __builtin_nontemporal_load((const h16x4*)(Z16 + (size_t)(r_) * DM + 4 * lane + 256 * j)); } while (0)
        if (gw < T_TOK) P9_LD(pa, gw);
        if (gw + NGW < T_TOK) P9_LD(pb, gw + NGW);
        for (int r = gw; r < T_TOK; r += NGW) {
            float* yr = Y + (size_t)r * DM;
            f32x4 v[4]; float s = 0.f;
#pragma unroll
            for (int j = 0; j < 4; ++j) { v[j] = __builtin_convertvector(pa[j], f32x4); pa[j] = pb[j]; s += (v[j][0] + v[j][1]) + (v[j][2] + v[j][3]); }
            if (r + 2 * NGW < T_TOK) P9_LD(pb, r + 2 * NGW);
            const float mean = wave_sum(s) * (1.0f / DM); float q = 0.f;
#pragma unroll
            for (int j = 0; j < 4; ++j) { const f32x4 d = v[j] - mean; q += (d[0] * d[0] + d[1] * d[1]) + (d[2] * d[2] + d[3] * d[3]); }
            const float rstd = 1.0f / sqrtf(wave_sum(q) * (1.0f / DM) + LN_EPS);
#pragma unroll
            for (int j = 0; j < 4; ++j) __builtin_nontemporal_store((v[j] - mean) * rstd * G2[j] + B2[j], (f32x4*)(yr + 4 * lane + 256 * j));
        }
#undef P9_LD
    }
}

extern "C" void kernel_launch(void* const* d_in, const int* in_sizes, int n_in, void* d_out, int out_size, void* d_ws, size_t ws_size, hipStream_t stream) {
    static int grid = 0;
    if (grid == 0) {
        if (n_in != 22 || out_size != T_TOK * DM || ws_size < WS_END) { fprintf(stderr, "kernel_launch: unexpected shapes (n_in %d, out %d, ws %zu)\n", n_in, out_size, ws_size); grid = -1; return; }
        int dev = 0, cus = 0, per_cu = 0;
        hipGetDevice(&dev);
        hipDeviceGetAttribute(&cus, hipDeviceAttributeMultiprocessorCount, dev);
        if (hipFuncSetAttribute((const void*)mega_fwd, hipFuncAttributeMaxDynamicSharedMemorySize, LDS_BYTES) != hipSuccess) { fprintf(stderr, "kernel_launch: hipFuncSetAttribute failed\n"); grid = -1; return; }
        if (hipOccupancyMaxActiveBlocksPerMultiprocessor(&per_cu, (const void*)mega_fwd, NWAVES * 64, LDS_BYTES) != hipSuccess || per_cu < 1) { fprintf(stderr, "kernel_launch: occupancy query failed (%d)\n", per_cu); per_cu = 1; }
        (void)hipGetLastError();
        grid = cus * per_cu;
        if (grid > 256) grid = 256;
        if (grid % 8) grid -= grid % 8;
        if (grid < 8) grid = 8;
    }
    if (grid < 0) return;
    hipMemsetAsync((char*)d_ws + WS_MOD, 0, WS_ZERO_BYTES, stream);
    Params p{};
    for (int i = 0; i < 22; ++i) p.in[i] = (const float*)d_in[i];
    p.out = (float*)d_out; p.ws = (unsigned char*)d_ws;
    void* args[] = {&p};
    hipError_t e = hipLaunchCooperativeKernel((const void*)mega_fwd, dim3(grid), dim3(NWAVES * 64), args, LDS_BYTES, stream);
    if (e != hipSuccess) fprintf(stderr, "kernel_launch: cooperative launch failed: %s (grid %d)\n", hipGetErrorString(e), grid);
}
```
